# Optimizing an MI355X kernel written in HIP

```python
import math
import jax
import jax.numpy as jnp
from jax import lax
import numpy as np

D_MODEL = 2048
BATCH = 16
SEQ = 256
DEPTH = 2
DEC_BATCH = 4
DEC_SEQ = 1024
PAST_LEN = 256

GRID_W = 64
HEAD_DIM = 64
GROUP_W = D_MODEL // 4
SWA_HEADS = GROUP_W // HEAD_DIM
SWA_KV_HEADS = 2
SWA_GROUP = SWA_HEADS // SWA_KV_HEADS
SWA_WINDOW = 128
SWA_BLOCK = 128
NA_HEADS = GROUP_W // HEAD_DIM
NA_KH = 8
NA_KW = 16
DIFF_HEADS = GROUP_W // (2 * HEAD_DIM)
DIFF_VDIM = 2 * HEAD_DIM
LRU_WIDTH = GROUP_W
LRU_BLOCKS = 8
LRU_BLOCK_W = LRU_WIDTH // LRU_BLOCKS
LRU_C = 8.0
CONV_W = 4
FFN_HIDDEN = (-(-8 * D_MODEL // 3) + 255) // 256 * 256
Q_BLOCK = 128
ROPE_BASE = 10000.0
NORM_EPS = 1e-6
NEG_INF = -1e30
MOD_CHUNKS = 6
PROJ_SIZES = (SWA_HEADS * HEAD_DIM, SWA_KV_HEADS * HEAD_DIM, SWA_KV_HEADS * HEAD_DIM,
              NA_HEADS * HEAD_DIM, NA_HEADS * HEAD_DIM, NA_HEADS * HEAD_DIM,
              DIFF_HEADS * 2 * HEAD_DIM, DIFF_HEADS * 2 * HEAD_DIM, DIFF_HEADS * DIFF_VDIM,
              LRU_WIDTH, LRU_WIDTH)
PROJ_W = sum(PROJ_SIZES)
MIX_W = SWA_HEADS * HEAD_DIM + NA_HEADS * HEAD_DIM + DIFF_HEADS * DIFF_VDIM + LRU_WIDTH

kernel_name = 'hybrid_parallel_heads_flow_step'


def _rms(x, g):
    xf = x.astype(jnp.float32)
    y = xf * lax.rsqrt(jnp.mean(xf * xf, axis=-1, keepdims=True) + NORM_EPS)
    return (y * g.astype(jnp.float32)).astype(x.dtype)


def _modulation(cvec, w_mod, b_mod):
    m = jax.nn.silu(cvec) @ w_mod + b_mod
    return jnp.split(m, MOD_CHUNKS, axis=-1)


def _modnorm(x, g, shift, scale):
    return _rms(x, g) * (1 + scale) + shift


def _swiglu(h, wg, wu, wd):
    return (jax.nn.silu(h @ wg) * (h @ wu)) @ wd


def _axial_angles(n_tok):
    t = jnp.arange(n_tok)
    pos = jnp.stack([t // GRID_W, t % GRID_W], axis=-1).astype(jnp.float32)
    nf = HEAD_DIM // 4
    inv = ROPE_BASE ** (-jnp.arange(nf, dtype=jnp.float32) / nf)
    return pos[:, :, None] * inv


def _rope(x, ang):
    nf = HEAD_DIM // 4
    shp = x.shape
    bshape = (1, shp[1]) + (1,) * (x.ndim - 3) + (2, nf)
    cos = jnp.cos(ang).reshape(bshape)
    sin = jnp.sin(ang).reshape(bshape)
    xf = x.astype(jnp.float32).reshape(shp[:-1] + (2, 2, nf))
    x1, x2 = xf[..., 0, :], xf[..., 1, :]
    out = jnp.stack([x1 * cos - x2 * sin, x2 * cos + x1 * sin], axis=-2)
    return out.reshape(shp).astype(x.dtype)


def _project(h, w_in, qk_gain):
    p = h @ w_in
    b, t, _ = p.shape
    parts = []
    off = 0
    for size in PROJ_SIZES:
        parts.append(p[..., off:off + size])
        off += size
    sq, sk, sv, nq, nk, nv, dq, dk, dv, lx, lg = parts
    sq = _rms(sq.reshape(b, t, SWA_KV_HEADS, SWA_GROUP, HEAD_DIM), qk_gain[0, 0])
    sk = _rms(sk.reshape(b, t, SWA_KV_HEADS, HEAD_DIM), qk_gain[0, 1])
    sv = sv.reshape(b, t, SWA_KV_HEADS, HEAD_DIM)
    nq = _rms(nq.reshape(b, t, NA_HEADS, HEAD_DIM), qk_gain[1, 0])
    nk = _rms(nk.reshape(b, t, NA_HEADS, HEAD_DIM), qk_gain[1, 1])
    nv = nv.reshape(b, t, NA_HEADS, HEAD_DIM)
    dq = _rms(dq.reshape(b, t, DIFF_HEADS, 2, HEAD_DIM), qk_gain[2, 0])
    dk = _rms(dk.reshape(b, t, DIFF_HEADS, 2, HEAD_DIM), qk_gain[2, 1])
    dv = dv.reshape(b, t, DIFF_HEADS, DIFF_VDIM)
    return sq, sk, sv, nq, nk, nv, dq, dk, dv, lx, lg


def _dense_attn(q, k, v, sink):
    b, t, hk, g, d = q.shape
    nb = t // Q_BLOCK
    scale = d ** -0.5
    qb = jnp.moveaxis(q.reshape(b, nb, Q_BLOCK, hk, g, d), 1, 0)

    def one(qblk):
        s = jnp.einsum('bqhgd,bshd->bhgqs', qblk, k).astype(jnp.float32) * scale
        if sink is None:
            p = jax.nn.softmax(s, axis=-1)
        else:
            s_sink = jnp.broadcast_to(sink.astype(jnp.float32)[None, :, :, None, None], s.shape[:-1] + (1,))
            p = jax.nn.softmax(jnp.concatenate([s, s_sink], axis=-1), axis=-1)[..., :-1]
        return jnp.einsum('bhgqs,bshe->bqhge', p.astype(v.dtype), v)

    o = lax.map(one, qb)
    return jnp.moveaxis(o, 0, 1).reshape(b, t, hk, g, -1)


def _diff_attn(q, k, v, lam):
    b, t, h, _, d = q.shape
    nb = t // Q_BLOCK
    scale = d ** -0.5
    qb = jnp.moveaxis(q.reshape(b, nb, Q_BLOCK, h, 2, d), 1, 0)

    def one(qblk):
        s = jnp.einsum('bqhid,bshid->bihqs', qblk, k).astype(jnp.float32) * scale
        p = jax.nn.softmax(s, axis=-1)
        pd = p[:, 0] - lam * p[:, 1]
        return jnp.einsum('bhqs,bshe->bqhe', pd.astype(v.dtype), v)

    o = lax.map(one, qb)
    return jnp.moveaxis(o, 0, 1).reshape(b, t, h, -1)


def _lambda_init(layer):
    return 0.8 - 0.6 * math.exp(-0.3 * layer)


def _diff_lambda(lp, lam_init):
    lp = lp.astype(jnp.float32)
    return jnp.exp(jnp.sum(lp[0] * lp[1])) - jnp.exp(jnp.sum(lp[2] * lp[3])) + lam_init


def _diff_out(o, subln, lam_init):
    b, t, h, e = o.shape
    return (_rms(o, subln) * (1.0 - lam_init)).reshape(b, t, h * e)


def _swa_latent(q, k, v, k_ctx, v_ctx, sink):
    b, t, hk, g, d = q.shape
    nb = t // SWA_BLOCK
    span = 3 * SWA_BLOCK
    scale = d ** -0.5
    pad = ((0, 0), (SWA_BLOCK, SWA_BLOCK), (0, 0), (0, 0))
    idx = np.arange(nb)[:, None] * SWA_BLOCK + np.arange(span)[None, :]
    kb = jnp.pad(k, pad)[:, idx]
    vb = jnp.pad(v, pad)[:, idx]
    qb = q.reshape(b, nb, SWA_BLOCK, hk, g, d)
    s_loc = jnp.einsum('bnqhgd,bnkhd->bnhgqk', qb, kb).astype(jnp.float32) * scale
    qpos = np.arange(t).reshape(nb, SWA_BLOCK)
    kpos = idx - SWA_BLOCK
    valid = ((kpos[:, None, :] >= 0) & (kpos[:, None, :] < t)
             & (np.abs(qpos[:, :, None] - kpos[:, None, :]) <= SWA_WINDOW))
    s_loc = jnp.where(valid[None, :, None, None], s_loc, NEG_INF)
    s_ctx = jnp.einsum('bnqhgd,bshd->bnhgqs', qb, k_ctx).astype(jnp.float32) * scale
    s_sink = jnp.broadcast_to(sink.astype(jnp.float32)[None, None, :, :, None, None], s_loc.shape[:-1] + (1,))
    p = jax.nn.softmax(jnp.concatenate([s_loc, s_ctx, s_sink], axis=-1), axis=-1).astype(v.dtype)
    n_ctx = k_ctx.shape[1]
    o = (jnp.einsum('bnhgqk,bnkhe->bnqhge', p[..., :span], vb)
         + jnp.einsum('bnhgqs,bshe->bnqhge', p[..., span:span + n_ctx], v_ctx))
    return o.reshape(b, t, hk, g, -1)


def _na_latent(q, k, v, k_ctx, v_ctx, rpb):
    b, t, h, d = q.shape
    rows = t // GRID_W
    kh = min(NA_KH, rows)
    n_loc = kh * GRID_W
    scale = d ** -0.5
    r = np.arange(rows)
    row_idx = np.clip(r - kh // 2, 0, rows - kh)[:, None] + np.arange(kh)[None, :]
    cq = np.arange(GRID_W)
    col_start = np.clip(cq - NA_KW // 2, 0, GRID_W - NA_KW)
    kg = k.reshape(b, rows, GRID_W, h, d)[:, row_idx].reshape(b, rows, n_loc, h, d)
    vg = v.reshape(b, rows, GRID_W, h, d)[:, row_idx].reshape(b, rows, n_loc, h, d)
    qg = q.reshape(b, rows, GRID_W, h, d)
    s_loc = jnp.einsum('brqhd,brkhd->brhqk', qg, kg).astype(jnp.float32) * scale
    dr = row_idx - r[:, None] + (NA_KH - 1)
    dc = np.clip(cq[None, :] - cq[:, None] + (NA_KW - 1), 0, 2 * NA_KW - 2)
    bias = rpb[:, dr[:, None, :, None], dc[None, :, None, :]]
    bias = jnp.moveaxis(bias.reshape(h, rows, GRID_W, n_loc), 0, 1).astype(jnp.float32)
    col_ok = (cq[None, :] >= col_start[:, None]) & (cq[None, :] < col_start[:, None] + NA_KW)
    col_ok = np.tile(col_ok, (1, kh))
    s_loc = jnp.where(col_ok, s_loc + bias, NEG_INF)
    s_ctx = jnp.einsum('brqhd,bshd->brhqs', qg, k_ctx).astype(jnp.float32) * scale
    p = jax.nn.softmax(jnp.concatenate([s_loc, s_ctx], axis=-1), axis=-1).astype(v.dtype)
    o = (jnp.einsum('brhqk,brkhe->brqhe', p[..., :n_loc], vg)
         + jnp.einsum('brhqs,bshe->brqhe', p[..., n_loc:], v_ctx))
    return o.reshape(b, t, h, -1)


def _dwconv_centred(x, w, bias):
    n = x.shape[1]
    left = CONV_W // 2
    xp = jnp.pad(x, ((0, 0), (left, CONV_W - 1 - left), (0, 0)))
    y = bias
    for tap in range(CONV_W):
        y = y + w[tap] * xp[:, tap:tap + n]
    return y


def _lin_combine(left, right):
    a1, b1 = left
    a2, b2 = right
    return a1 * a2, a2 * b1 + b2


def _lru_scan(u, w_a, b_a, w_x, b_x, lam_l, h0, reverse):
    b, t, ch = u.shape
    uf = u.astype(jnp.float32)
    ub = uf.reshape(b, t, LRU_BLOCKS, LRU_BLOCK_W)
    r = jax.nn.sigmoid(jnp.einsum('btnc,ncd->btnd', ub, w_a.astype(jnp.float32)).reshape(b, t, ch) + b_a)
    i = jax.nn.sigmoid(jnp.einsum('btnc,ncd->btnd', ub, w_x.astype(jnp.float32)).reshape(b, t, ch) + b_x)
    log_a = -LRU_C * r * jax.nn.softplus(-lam_l.astype(jnp.float32))
    a = jnp.exp(log_a)
    bx = jnp.sqrt(-jnp.expm1(2.0 * log_a)) * (i * uf)
    edge = t - 1 if reverse else 0
    bx = bx.at[:, edge].add(a[:, edge] * h0.astype(jnp.float32))
    _, hs = lax.associative_scan(_lin_combine, (a, bx), axis=1, reverse=reverse)
    final = hs[:, 0] if reverse else hs[:, -1]
    return hs, final


def _lru_mixer(xb, gb, conv_w, conv_b, wa, ba, wx, bx, lam_l, h0):
    u = _dwconv_centred(xb, conv_w, conv_b)
    hf, sf = _lru_scan(u, wa[0], ba[0], wx[0], bx[0], lam_l[0], h0[:, 0], False)
    hb, sb = _lru_scan(u, wa[1], ba[1], wx[1], bx[1], lam_l[1], h0[:, 1], True)
    y = ((hf + hb) * jax.nn.gelu(gb.astype(jnp.float32))).astype(xb.dtype)
    return y, jnp.stack([sf, sb], axis=1).astype(xb.dtype)


def setup_inputs(seed: int = 0) -> dict:
    key = jax.random.key(seed)
    ks = iter(jax.random.split(key, 40))
    f32 = jnp.float32
    D = D_MODEL

    def nrm(shape, scale):
        return jax.random.normal(next(ks), shape, f32) * scale

    x_prompt = nrm((BATCH, SEQ, D), 1.0)
    x_sample = nrm((DEC_BATCH, DEC_SEQ, D), 1.0)
    cache_swa_k = nrm((DEC_BATCH, DEPTH, PAST_LEN, SWA_KV_HEADS, HEAD_DIM), 1.0)
    cache_swa_v = nrm((DEC_BATCH, DEPTH, PAST_LEN, SWA_KV_HEADS, HEAD_DIM), 1.0)
    cache_na_k = nrm((DEC_BATCH, DEPTH, PAST_LEN, NA_HEADS, HEAD_DIM), 1.0)
    cache_na_v = nrm((DEC_BATCH, DEPTH, PAST_LEN, NA_HEADS, HEAD_DIM), 1.0)
    cache_diff_k = nrm((DEC_BATCH, DEPTH, PAST_LEN, DIFF_HEADS, 2, HEAD_DIM), 1.0)
    cache_diff_v = nrm((DEC_BATCH, DEPTH, PAST_LEN, DIFF_HEADS, DIFF_VDIM), 1.0)
    state_lru = nrm((DEC_BATCH, DEPTH, 2, LRU_WIDTH), 0.5)
    c = nrm((DEC_BATCH, D), 1.0)
    c_ctx = nrm((D,), 1.0)
    norm_mix = 1.0 + nrm((DEPTH, D), 0.02)
    norm_ffn = 1.0 + nrm((DEPTH, D), 0.02)
    w_mod = nrm((DEPTH, D, MOD_CHUNKS * D), 0.5 * D ** -0.5)
    b_mod = nrm((DEPTH, MOD_CHUNKS * D), 0.02)
    w_in = nrm((DEPTH, D, PROJ_W), D ** -0.5)
    w_out = nrm((DEPTH, MIX_W, D), MIX_W ** -0.5)
    qk_gain = 1.0 + nrm((DEPTH, 3, 2, HEAD_DIM), 0.02)
    swa_sink = nrm((DEPTH, SWA_HEADS), 0.5)
    na_rpb = nrm((DEPTH, NA_HEADS, 2 * NA_KH - 1, 2 * NA_KW - 1), 0.1)
    diff_lambda = nrm((DEPTH, 4, HEAD_DIM), 0.1)
    diff_subln = 1.0 + nrm((DEPTH, DIFF_VDIM), 0.02)
    conv_w = nrm((DEPTH, CONV_W, LRU_WIDTH), CONV_W ** -0.5)
    conv_b = nrm((DEPTH, LRU_WIDTH), 0.02)
    lru_wa = nrm((DEPTH, 2, LRU_BLOCKS, LRU_BLOCK_W, LRU_BLOCK_W), LRU_BLOCK_W ** -0.5)
    lru_ba = nrm((DEPTH, 2, LRU_WIDTH), 0.02)
    lru_wx = nrm((DEPTH, 2, LRU_BLOCKS, LRU_BLOCK_W, LRU_BLOCK_W), LRU_BLOCK_W ** -0.5)
    lru_bx = nrm((DEPTH, 2, LRU_WIDTH), 0.02)
    a_c = jax.random.uniform(next(ks), (DEPTH, 2, LRU_WIDTH), f32, 0.9, 0.999)
    a_base = a_c ** (1.0 / LRU_C)
    lru_L = jnp.log(a_base) - jnp.log1p(-a_base)
    w_ffn_gate = nrm((DEPTH, D, FFN_HIDDEN), D ** -0.5)
    w_ffn_up = nrm((DEPTH, D, FFN_HIDDEN), D ** -0.5)
    w_ffn_down = nrm((DEPTH, FFN_HIDDEN, D), FFN_HIDDEN ** -0.5)
    return {'x_prompt': x_prompt, 'x_sample': x_sample,
            'cache_swa_k': cache_swa_k, 'cache_swa_v': cache_swa_v,
            'cache_na_k': cache_na_k, 'cache_na_v': cache_na_v,
            'cache_diff_k': cache_diff_k, 'cache_diff_v': cache_diff_v,
            'state_lru': state_lru, 'c': c, 'c_ctx': c_ctx,
            'norm_mix': norm_mix, 'norm_ffn': norm_ffn, 'w_mod': w_mod, 'b_mod': b_mod,
            'w_in': w_in, 'w_out': w_out, 'qk_gain': qk_gain, 'swa_sink': swa_sink,
            'na_rpb': na_rpb, 'diff_lambda': diff_lambda, 'diff_subln': diff_subln,
            'conv_w': conv_w, 'conv_b': conv_b, 'lru_wa': lru_wa, 'lru_ba': lru_ba,
            'lru_wx': lru_wx, 'lru_bx': lru_bx, 'lru_L': lru_L,
            'w_ffn_gate': w_ffn_gate, 'w_ffn_up': w_ffn_up, 'w_ffn_down': w_ffn_down}


def reference(x_prompt, x_sample, cache_swa_k, cache_swa_v, cache_na_k, cache_na_v,
              cache_diff_k, cache_diff_v, state_lru, c, c_ctx,
              norm_mix, norm_ffn, w_mod, b_mod, w_in, w_out, qk_gain, swa_sink,
              na_rpb, diff_lambda, diff_subln, conv_w, conv_b, lru_wa, lru_ba,
              lru_wx, lru_bx, lru_L, w_ffn_gate, w_ffn_up, w_ffn_down):
    xc = x_prompt
    bc, s_ctx, _ = xc.shape
    swa_k_l, swa_v_l, na_k_l, na_v_l, diff_k_l, diff_v_l, lru_s_l = [], [], [], [], [], [], []
    for l in range(DEPTH):
        lam_init = _lambda_init(l)
        sh1, sc1, g1, sh2, sc2, g2 = _modulation(c_ctx, w_mod[l], b_mod[l])
        h = _modnorm(xc, norm_mix[l], sh1, sc1)
        sq, sk, sv, nq, nk, nv, dq, dk, dv, lx, lg = _project(h, w_in[l], qk_gain[l])
        oa = _dense_attn(sq, sk, sv, swa_sink[l].reshape(SWA_KV_HEADS, SWA_GROUP))
        ob = _dense_attn(nq[:, :, :, None], nk, nv, None)
        lam = _diff_lambda(diff_lambda[l], lam_init)
        oc = _diff_out(_diff_attn(dq, dk, dv, lam), diff_subln[l], lam_init)
        h0 = jnp.zeros((bc, 2, LRU_WIDTH), xc.dtype)
        od, st = _lru_mixer(lx, lg, conv_w[l], conv_b[l], lru_wa[l], lru_ba[l],
                            lru_wx[l], lru_bx[l], lru_L[l], h0)
        mix = jnp.concatenate([oa.reshape(bc, s_ctx, -1), ob.reshape(bc, s_ctx, -1), oc, od], axis=-1)
        xc = xc + g1 * (mix @ w_out[l])
        xc = xc + g2 * _swiglu(_modnorm(xc, norm_ffn[l], sh2, sc2),
                               w_ffn_gate[l], w_ffn_up[l], w_ffn_down[l])
        swa_k_l.append(sk)
        swa_v_l.append(sv)
        na_k_l.append(nk)
        na_v_l.append(nv)
        diff_k_l.append(dk)
        diff_v_l.append(dv)
        lru_s_l.append(st)
    y_prompt = xc
    new_swa_k = jnp.stack(swa_k_l, axis=1)
    new_swa_v = jnp.stack(swa_v_l, axis=1)
    new_na_k = jnp.stack(na_k_l, axis=1)
    new_na_v = jnp.stack(na_v_l, axis=1)
    new_diff_k = jnp.stack(diff_k_l, axis=1)
    new_diff_v = jnp.stack(diff_v_l, axis=1)
    new_state_lru = jnp.stack(lru_s_l, axis=1)

    xs = x_sample
    bd, t_lat, _ = xs.shape
    ang = _axial_angles(t_lat)
    for l in range(DEPTH):
        lam_init = _lambda_init(l)
        sh1, sc1, g1, sh2, sc2, g2 = [m[:, None, :] for m in _modulation(c, w_mod[l], b_mod[l])]
        h = _modnorm(xs, norm_mix[l], sh1, sc1)
        sq, sk, sv, nq, nk, nv, dq, dk, dv, lx, lg = _project(h, w_in[l], qk_gain[l])
        oa = _swa_latent(_rope(sq, ang), _rope(sk, ang), sv, cache_swa_k[:, l], cache_swa_v[:, l],
                         swa_sink[l].reshape(SWA_KV_HEADS, SWA_GROUP))
        ob = _na_latent(nq, nk, nv, cache_na_k[:, l], cache_na_v[:, l], na_rpb[l])
        k_all = jnp.concatenate([_rope(dk, ang), cache_diff_k[:, l]], axis=1)
        v_all = jnp.concatenate([dv, cache_diff_v[:, l]], axis=1)
        lam = _diff_lambda(diff_lambda[l], lam_init)
        oc = _diff_out(_diff_attn(_rope(dq, ang), k_all, v_all, lam), diff_subln[l], lam_init)
        od, _ = _lru_mixer(lx, lg, conv_w[l], conv_b[l], lru_wa[l], lru_ba[l],
                           lru_wx[l], lru_bx[l], lru_L[l], state_lru[:, l])
        mix = jnp.concatenate([oa.reshape(bd, t_lat, -1), ob.reshape(bd, t_lat, -1), oc, od], axis=-1)
        xs = xs + g1 * (mix @ w_out[l])
        xs = xs + g2 * _swiglu(_modnorm(xs, norm_ffn[l], sh2, sc2),
                               w_ffn_gate[l], w_ffn_up[l], w_ffn_down[l])
    y_sample = xs
    return (y_prompt, y_sample, new_swa_k, new_swa_v, new_na_k, new_na_v,
            new_diff_k, new_diff_v, new_state_lru)
```

```cpp
#include <hip/hip_runtime.h>
#include <cstdio>
#include <cstdint>
#include <cstddef>
namespace pg8 {
#define PG8_LAS __attribute__((address_space(3)))
typedef unsigned short bf16_t;
typedef short bf16x8 __attribute__((ext_vector_type(8)));
typedef float f32x4 __attribute__((ext_vector_type(4)));
typedef unsigned u32x4 __attribute__((ext_vector_type(4)));
constexpr int BM = 256, BK = 64, HALF = 128, HTB = HALF * BK * 2  , STAGE_BYTES = 8 * HTB, NXCD = 8, WGM = 8;

__host__ __device__ __forceinline__ int lds_byte(int r, int c) { const int st = (r >> 4) * 2 + (c >> 5), rr = r & 15, cc = c & 31, ob = rr * 64 + cc * 2; return st * 1024 + (ob ^ (((ob >> 9) & 1) << 5)); }
__host__ __device__ __forceinline__ void stage_rc(int b, int& R, int& C) { const int st = b / 1024, sb = b % 1024, swz = sb ^ (((sb >> 9) & 1) << 5); R = (st >> 1) * 16 + swz / 64; C = (st & 1) * 32 + (swz % 64) / 2; }
__host__ __device__ __forceinline__ int perm32(int rho) { const int n = rho >> 4, i = rho & 15; return 8 * (i >> 2) + 4 * n + (i & 3); }

struct Unit { int pm, pn; };
struct Gemm { const bf16_t* A; const bf16_t* Bt; int M, N, K; };

struct StaticOrder {
    int nM, nN, nwg, G, c;
    __host__ __device__ void init(int M, int N, int G_, int c_) { nM = M / BM; nN = N / BM; nwg = nM * nN; G = G_; c = c_; }
    __host__ __device__ bool next(int i, Unit& u) const {
        const long L = (long)i * G + c; if (L >= nwg) return false;
        int wgid = (int)L; { const int q = nwg / NXCD, r = nwg % NXCD, xcd = wgid % NXCD, off = wgid / NXCD; wgid = (xcd < r ? xcd * (q + 1) : r * (q + 1) + (xcd - r) * q) + off; }
        const int nig = WGM * nN, gid = wgid / nig, fm = gid * WGM, gsz = (nM - fm) < WGM ? (nM - fm) : WGM;
        u.pm = fm + ((wgid % nig) % gsz); u.pn = (wgid % nig) / gsz; return true;
    }
    __device__ __forceinline__ void a_ready(const Unit&) const {}
    __device__ __forceinline__ void done(const Unit&) const {}
};

__device__ __forceinline__ unsigned cvt_pk_bf16(float lo, float hi) { unsigned r; asm volatile("v_cvt_pk_bf16_f32 %0, %1, %2" : "=v"(r) : "v"(lo), "v"(hi)); return r; }
template <class Epi, class Sched, bool ALIGN_EPI = false, bool SP2 = false>
__device__ __forceinline__ void gemm_phase(PG8_LAS unsigned char* lds, const Gemm g, const Sched& S, const Epi& E) {
    const int tid = threadIdx.x, wid = __builtin_amdgcn_readfirstlane(tid >> 6), lane = tid & 63, wr = wid >> 2, wc = wid & 3, fr = lane & 15, fq = lane >> 4;
    const int K = g.K, nt = K / BK;
    unsigned voffA[2], voffB[2];
#pragma unroll
    for (int i = 0; i < 2; ++i) { int R, C; stage_rc(tid * 16 + i * 8192, R, C); const int Rb = Epi::PERM ? ((R & ~31) + perm32(R & 31)) : R;
        voffA[i] = (unsigned)(R * K + C) * 2u; voffB[i] = (unsigned)(Rb * K + C) * 2u; }
    const size_t kstep = (size_t)(BK * 2);
    const size_t hstep = (size_t)HALF * K * 2;
    const size_t tstep = 2 * hstep;
    const unsigned ldsw = (unsigned)wid * 1024u;
    const int aoff = lds_byte(wr * 64 + fr, fq * 8), boff = lds_byte(wc * 32 + fr, fq * 8);
#define PG8_SA(b, h) (((b) * 2 + (h)) * HTB)
#define PG8_SB(b, h) ((4 + (b) * 2 + (h)) * HTB)
#define PG8_STAGE(bufoff, gbase, voff) do { _Pragma("unroll") for (int _i = 0; _i < 2; ++_i) \
        __builtin_amdgcn_global_load_lds((const unsigned*)((const char*)(gbase) + (voff)[_i]), (PG8_LAS unsigned*)(lds + (bufoff) + ldsw + _i * 8192), 16, 0, 0); } while (0)
#define PG8_LDA(dst, b, h) do { _Pragma("unroll") for (int m = 0; m < 4; ++m) _Pragma("unroll") for (int k = 0; k < 2; ++k) dst[m][k] = *(const PG8_LAS bf16x8*)(lds + PG8_SA(b, h) + aoff + m * 2048 + k * 1024); } while (0)
#define PG8_LDB(dst, b, h) do { _Pragma("unroll") for (int n = 0; n < 2; ++n) _Pragma("unroll") for (int k = 0; k < 2; ++k) dst[n][k] = *(const PG8_LAS bf16x8*)(lds + PG8_SB(b, h) + boff + n * 2048 + k * 1024); } while (0)
#define PG8_MMA(ai, bj, At, Bt) do { __builtin_amdgcn_s_setprio(1); _Pragma("unroll") for (int m = 0; m < 4; ++m) _Pragma("unroll") for (int n = 0; n < 2; ++n) _Pragma("unroll") for (int k = 0; k < 2; ++k) \
        acc[ai][bj][m][n] = __builtin_amdgcn_mfma_f32_16x16x32_bf16(Bt[n][k], At[m][k], acc[ai][bj][m][n], 0, 0, 0); __builtin_amdgcn_s_setprio(0); } while (0)
#define PG8_WAIT_V(n) asm volatile("s_waitcnt vmcnt(" #n ")" ::: "memory")
#define PG8_WAIT_L(n) asm volatile("s_waitcnt lgkmcnt(" #n ")" ::: "memory")
#define PG8_BAR __builtin_amdgcn_s_barrier()
#define PG8_SCHED __builtin_amdgcn_sched_barrier(0)
    Unit cur, nxt; int ui = 0;
    if (!S.next(0, cur)) return;
    f32x4 acc[2][2][4][2];
#pragma unroll
    for (int a = 0; a < 2; ++a)
#pragma unroll
        for (int b = 0; b < 2; ++b)
#pragma unroll
            for (int m = 0; m < 4; ++m)
#pragma unroll
                for (int n = 0; n < 2; ++n) acc[a][b][m][n] = (f32x4){0.f, 0.f, 0.f, 0.f};
    bf16x8 At[4][2], B0[2][2], B1[2][2];
    const char* cA = (const char*)g.A + (size_t)cur.pm * tstep; const char* cB = (const char*)g.Bt + (size_t)cur.pn * tstep;
    S.a_ready(cur);
    if constexpr (SP2) {
        PG8_STAGE(PG8_SB(0, 0), cB, voffB); PG8_STAGE(PG8_SB(0, 1), cB + hstep, voffB); PG8_STAGE(PG8_SA(0, 0), cA, voffA); PG8_STAGE(PG8_SA(0, 1), cA + hstep, voffA);
        if (wr == 1) PG8_BAR;
        PG8_WAIT_V(2); PG8_BAR;
        PG8_STAGE(PG8_SB(1, 0), cB + kstep, voffB); PG8_STAGE(PG8_SA(1, 0), cA + kstep, voffA); PG8_STAGE(PG8_SB(1, 1), cB + hstep + kstep, voffB);
        PG8_WAIT_V(6); PG8_BAR;
    } else {
        PG8_STAGE(PG8_SB(0, 0), cB, voffB); PG8_STAGE(PG8_SA(0, 0), cA, voffA); PG8_STAGE(PG8_SB(0, 1), cB + hstep, voffB); PG8_STAGE(PG8_SA(0, 1), cA + hstep, voffA);
        if (wr == 1) PG8_BAR;
        PG8_WAIT_V(4); PG8_BAR;
        PG8_STAGE(PG8_SB(1, 0), cB + kstep, voffB); PG8_STAGE(PG8_SA(1, 0), cA + kstep, voffA); PG8_STAGE(PG8_SB(1, 1), cB + hstep + kstep, voffB);
        PG8_WAIT_V(6); PG8_BAR;
    }
    for (;;) {
        const bool has_next = S.next(ui + 1, nxt);
        const char* nA = has_next ? (const char*)g.A + (size_t)nxt.pm * tstep : cA; const char* nB = has_next ? (const char*)g.Bt + (size_t)nxt.pn * tstep : cB;
        for (int t = 0; t < nt; t += 2) {
            const bool last = (t == nt - 2);
            const char* a1 = cA + (size_t)(t + 1) * kstep;
            const char* a2 = last ? nA : cA + (size_t)(t + 2) * kstep; const char* b2 = last ? nB : cB + (size_t)(t + 2) * kstep;
            const char* a3 = a2 + kstep; const char* b3 = b2 + kstep;
            if (last && has_next) S.a_ready(nxt);
            if constexpr (SP2) {
            PG8_LDB(B0, 0, 0); PG8_LDB(B1, 0, 1); PG8_SCHED; PG8_LDA(At, 0, 0); PG8_STAGE(PG8_SA(1, 1), a1 + hstep, voffA);
            PG8_WAIT_V(8); PG8_WAIT_L(0); PG8_BAR; PG8_MMA(0, 0, At, B0); PG8_MMA(0, 1, At, B1); PG8_BAR; PG8_SCHED;
            PG8_LDA(At, 0, 1); PG8_STAGE(PG8_SB(0, 0), b2, voffB); PG8_STAGE(PG8_SB(0, 1), b2 + hstep, voffB); PG8_STAGE(PG8_SA(0, 0), a2, voffA);
            PG8_WAIT_V(8); PG8_WAIT_L(0); PG8_BAR; PG8_MMA(1, 0, At, B0); PG8_MMA(1, 1, At, B1); PG8_BAR; PG8_SCHED;
            PG8_LDB(B0, 1, 0); PG8_LDB(B1, 1, 1); PG8_SCHED; PG8_LDA(At, 1, 0); PG8_STAGE(PG8_SA(0, 1), a2 + hstep, voffA);
            PG8_WAIT_V(8); PG8_WAIT_L(0); PG8_BAR; PG8_MMA(0, 0, At, B0); PG8_MMA(0, 1, At, B1); PG8_BAR; PG8_SCHED;
            PG8_LDA(At, 1, 1); PG8_STAGE(PG8_SB(1, 0), b3, voffB); PG8_STAGE(PG8_SB(1, 1), b3 + hstep, voffB); PG8_STAGE(PG8_SA(1, 0), a3, voffA);
            PG8_WAIT_V(8); PG8_WAIT_L(0); PG8_BAR; PG8_MMA(1, 0, At, B0); PG8_MMA(1, 1, At, B1); PG8_BAR; PG8_SCHED;
            } else {
            PG8_LDB(B0, 0, 0); PG8_SCHED; PG8_LDA(At, 0, 0); PG8_STAGE(PG8_SA(1, 1), a1 + hstep, voffA);
            PG8_WAIT_L(8); PG8_BAR; PG8_WAIT_L(0); PG8_MMA(0, 0, At, B0); PG8_BAR; PG8_SCHED;
            PG8_LDB(B1, 0, 1); PG8_STAGE(PG8_SB(0, 0), b2, voffB);
            PG8_BAR; PG8_WAIT_L(0); PG8_MMA(0, 1, At, B1); PG8_BAR;
            PG8_LDA(At, 0, 1); PG8_STAGE(PG8_SA(0, 0), a2, voffA);
            PG8_BAR; PG8_WAIT_L(0); PG8_MMA(1, 0, At, B0); PG8_BAR; PG8_SCHED;
            PG8_STAGE(PG8_SB(0, 1), b2 + hstep, voffB);
            PG8_WAIT_V(6); PG8_BAR; PG8_MMA(1, 1, At, B1); PG8_BAR;
            PG8_LDB(B0, 1, 0); PG8_SCHED; PG8_LDA(At, 1, 0); PG8_STAGE(PG8_SA(0, 1), a2 + hstep, voffA);
            PG8_WAIT_L(8); PG8_BAR; PG8_WAIT_L(0); PG8_MMA(0, 0, At, B0); PG8_BAR; PG8_SCHED;
            PG8_LDB(B1, 1, 1); PG8_STAGE(PG8_SB(1, 0), b3, voffB);
            PG8_BAR; PG8_WAIT_L(0); PG8_MMA(0, 1, At, B1); PG8_BAR;
            PG8_LDA(At, 1, 1); PG8_STAGE(PG8_SA(1, 0), a3, voffA);
            PG8_BAR; PG8_WAIT_L(0); PG8_MMA(1, 0, At, B0); PG8_BAR; PG8_SCHED;
            PG8_STAGE(PG8_SB(1, 1), b3 + hstep, voffB);
            PG8_WAIT_V(6); PG8_BAR; PG8_MMA(1, 1, At, B1); PG8_BAR;
            }
        }
        if constexpr (ALIGN_EPI) { if (wr == 0) PG8_BAR; }
        if constexpr (!Epi::AFTER_DRAIN) { E(acc, cur, wr, wc, fr, fq); S.done(cur); }
        if (!has_next) break;
#pragma unroll
        for (int a = 0; a < 2; ++a)
#pragma unroll
            for (int b = 0; b < 2; ++b)
#pragma unroll
                for (int m = 0; m < 4; ++m)
#pragma unroll
                    for (int n = 0; n < 2; ++n) acc[a][b][m][n] = (f32x4){0.f, 0.f, 0.f, 0.f};
        cur = nxt; cA = nA; cB = nB; ++ui;
        if constexpr (ALIGN_EPI) { if (wr == 1) PG8_BAR; }
    }
    PG8_WAIT_V(0);
    if constexpr (!ALIGN_EPI) { if (wr == 0) PG8_BAR; }
    PG8_BAR;
    if constexpr (Epi::AFTER_DRAIN) { E.fused(acc, cur, wr, wc, fr, fq, lds, wid, lane); S.done(cur); }
#undef PG8_SA
#undef PG8_SB
#undef PG8_STAGE
#undef PG8_LDA
#undef PG8_LDB
#undef PG8_MMA
#undef PG8_WAIT_V
#undef PG8_WAIT_L
#undef PG8_BAR
#undef PG8_SCHED
}
}
#define GAS __attribute__((address_space(1)))
#define LAS __attribute__((address_space(3)))
typedef unsigned short bf16;
typedef unsigned v4u __attribute__((ext_vector_type(4)));
typedef float f32x4 __attribute__((ext_vector_type(4)));
typedef short bf16x8 __attribute__((ext_vector_type(8)));
typedef GAS unsigned gu32;
typedef GAS unsigned long long gu64;
#define RLX_AGENT __ATOMIC_RELAXED, __HIP_MEMORY_SCOPE_AGENT
#define LDS_WAIT() asm volatile("s_waitcnt lgkmcnt(0)" ::: "memory")
#define VM_WAIT() asm volatile("s_waitcnt vmcnt(0)" ::: "memory")
__device__ __forceinline__ unsigned long long rt() { return __builtin_amdgcn_s_memrealtime(); }
__device__ __forceinline__ unsigned f2bf(float f) { unsigned u = __builtin_bit_cast(unsigned, f); return (u + 0x7fffu + ((u >> 16) & 1u)) >> 16; }
__device__ __forceinline__ unsigned pk2(float lo, float hi) { return f2bf(lo) | (f2bf(hi) << 16); }

#define XB_TMO      128
#define XB_XCNT(j)  (256  + 64 * (j))
#define XB_XSUB(j)  (1280 + 64 * (j))
#define XB_XGEN(j)  (2304 + 64 * (j))
#define XB_TOP      3328
#define XB_TOPGEN   3392
#define XCD_BAR_WORDS 3456
#define XB_SPIN_CAP (1u << 18)

__device__ __forceinline__ unsigned xb_ld(unsigned* p)              { return __hip_atomic_load(p, __ATOMIC_RELAXED, __HIP_MEMORY_SCOPE_AGENT); }
__device__ __forceinline__ unsigned xb_add(unsigned* p, unsigned v) { return __hip_atomic_fetch_add(p, v, __ATOMIC_RELAXED, __HIP_MEMORY_SCOPE_AGENT); }
__device__ __forceinline__ unsigned xb_xcc_id() { return (unsigned)__builtin_amdgcn_s_getreg((3 << 11) | 20) & 0xFu; }
#define XB_SPIN(cond, bar) do { unsigned _sp = 0; while (cond) { __builtin_amdgcn_s_sleep(1); \
    if ((++_sp & 255u) == 0u) { if (xb_ld(&(bar)[XB_TMO])) break; if (_sp > XB_SPIN_CAP) { atomicAdd(&(bar)[XB_TMO], 1u); break; } } } } while (0)

struct XcdBarrier {
    unsigned* bar; unsigned x;
    volatile LAS unsigned* st;
};

__device__ __forceinline__ XcdBarrier xcd_barrier_post(unsigned* bar, volatile LAS unsigned* st) {
    XcdBarrier b; b.bar = bar; b.x = xb_xcc_id(); b.st = st;
    if (threadIdx.x == 0) (void)xb_add(&bar[XB_XCNT(b.x)], 1u);
    return b;
}
__device__ __forceinline__ void xcd_barrier_complete(unsigned* bar, unsigned x, unsigned& nloc, unsigned& nx) {
    const unsigned G = gridDim.x * gridDim.y * gridDim.z;
    unsigned sum, cnt, mine, sp = 0u;
    for (;;) {
        sum = 0u; cnt = 0u; mine = 0u;
#pragma unroll
        for (unsigned j = 0; j < 16; ++j) { const unsigned c = xb_ld(&bar[XB_XCNT(j)]); sum += c; cnt += (c > 0u) ? 1u : 0u; mine = (j == x) ? c : mine; }
        if (sum == G) break;
        __builtin_amdgcn_s_sleep(1);
        if ((++sp & 255u) == 0u) { if (xb_ld(&bar[XB_TMO])) break; if (sp > XB_SPIN_CAP) { atomicAdd(&bar[XB_TMO], 1u); break; } }
    }
    nloc = mine > 0u ? mine : 1u; nx = cnt > 0u ? cnt : 1u;
}

__device__ __forceinline__ void xcd_barrier(const XcdBarrier& b) {
    asm volatile("s_waitcnt vmcnt(0)" ::: "memory");
    __syncthreads();
    if (threadIdx.x == 0) {
        unsigned* bar = b.bar;
        __builtin_amdgcn_s_waitcnt(0);
        unsigned nloc = b.st[0], nx = b.st[1];
        if (nloc == 0u) { xcd_barrier_complete(bar, b.x, nloc, nx); b.st[0] = nloc; b.st[1] = nx; }
        const unsigned old = xb_add(&bar[XB_XSUB(b.x)], 1u);
        const unsigned gen = old / nloc;
        if (old + 1u == (gen + 1u) * nloc) {
            __builtin_amdgcn_fence(__ATOMIC_RELEASE, "agent");
            asm volatile("s_waitcnt vmcnt(0)" ::: "memory");
            const unsigned og = xb_add(&bar[XB_TOP], 1u);
            const unsigned tg = og / nx;
            if (og + 1u == (tg + 1u) * nx) xb_add(&bar[XB_TOPGEN], 1u);
            else XB_SPIN(xb_ld(&bar[XB_TOPGEN]) == tg, bar);
            __builtin_amdgcn_fence(__ATOMIC_ACQUIRE, "agent");
            xb_add(&bar[XB_XGEN(b.x)], 1u);
            asm volatile("s_waitcnt vmcnt(0)" ::: "memory");
        } else {
            XB_SPIN(xb_ld(&bar[XB_XGEN(b.x)]) == gen, bar);
            __builtin_amdgcn_fence(__ATOMIC_ACQUIRE, "agent");
            asm volatile("s_waitcnt vmcnt(0)" ::: "memory");
        }
    }
    __syncthreads();
}
constexpr int DM = 2048, NTOK = 8192, NCTX = 4096, PROJW = 4864, FFNH = 5632, MODW = 12288;
constexpr int C_SQ = 0, C_SK = 512, C_SV = 640, C_NQ = 768, C_NK = 1280, C_NV = 1792, C_DQ = 2304, C_DK = 2816, C_DV = 3328, C_LX = 3840, C_LG = 4352;
constexpr size_t O_Y = 0, O_SWAK = 16777216, O_SWAV = 17825792, O_NAK = 18874368, O_NAV = 23068672, O_DFK = 27262976, O_DFV = 31457280, O_LRU = 35651584;
constexpr size_t MiB = 1u << 20;
constexpr size_t WS_CTL = 0, CTL_ZERO_BYTES = 1 * MiB;
constexpr int KSPLIT = 16;
constexpr size_t WS_MODP = 2 * MiB;
constexpr size_t WS_MODV = 10 * MiB;
constexpr size_t WS_WIN = 12 * MiB;
constexpr size_t WS_WOUT = 52 * MiB;
constexpr size_t WS_WGU = 68 * MiB;
constexpr size_t WS_WDN = 156 * MiB;
constexpr size_t WS_H = 200 * MiB;
constexpr size_t WS_MIX = 232 * MiB;
constexpr size_t WS_HM = 264 * MiB;
constexpr size_t WS_P = 352 * MiB;
constexpr size_t WS_U = 504 * MiB;
constexpr size_t WS_AB = 520 * MiB;
constexpr size_t WS_HS = 584 * MiB;
constexpr size_t WS_DT = 616 * MiB;
constexpr size_t WS_END = 648 * MiB;
constexpr int CW_BAR = 4096;

constexpr int NWAVES = 8;
constexpr int RING_BYTES = 131072, LDSCTL_OFF = RING_BYTES, MISC_OFF = LDSCTL_OFF + 320, LDS_BYTES = 147456;

__device__ __forceinline__ float bf2f(unsigned short b) { return __builtin_bit_cast(float, (unsigned)b << 16); }

struct EpiF32P {
    static constexpr bool PERM = false, AFTER_DRAIN = false;
    float* C; int ldc;
    __device__ __forceinline__ void operator()(const pg8::f32x4 (&acc)[2][2][4][2], const pg8::Unit& u, int wr, int wc, int fr, int fq) const {
        const int row0 = u.pm * 256 + wr * 64 + fr, col0 = u.pn * 256 + wc * 32 + 4 * fq;
#pragma unroll
        for (int ai = 0; ai < 2; ++ai)
#pragma unroll
            for (int m = 0; m < 4; ++m) { float* rowp = C + (size_t)(row0 + ai * 128 + m * 16) * ldc + col0;
#pragma unroll
                for (int bj = 0; bj < 2; ++bj)
#pragma unroll
                    for (int n = 0; n < 2; ++n) *(pg8::f32x4*)(rowp + bj * 128 + n * 16) = acc[ai][bj][m][n]; }
    }
};
struct EpiResid {
    static constexpr bool PERM = false, AFTER_DRAIN = false;
    const float* b0; const float* b1; float* out; const float* gate;
    __device__ __forceinline__ void operator()(const pg8::f32x4 (&acc)[2][2][4][2], const pg8::Unit& u, int wr, int wc, int fr, int fq) const {
        const int v = u.pm < 16 ? 0 : 1 + ((u.pm - 16) >> 2);
        const float* bp = u.pm < 16 ? b0 + (size_t)u.pm * 256 * DM : b1 + (size_t)(u.pm - 16) * 256 * DM;
        float* op = out + (size_t)u.pm * 256 * DM;
        const int r0 = wr * 64 + fr, col0 = u.pn * 256 + wc * 32 + 4 * fq;
        pg8::f32x4 gv[2][2];
#pragma unroll
        for (int bj = 0; bj < 2; ++bj)
#pragma unroll
            for (int n = 0; n < 2; ++n) gv[bj][n] = *(const pg8::f32x4*)(gate + (size_t)v * MODW + col0 + bj * 128 + n * 16);
#pragma unroll
        for (int ai = 0; ai < 2; ++ai)
#pragma unroll
            for (int m = 0; m < 4; ++m) { const size_t off = (size_t)(r0 + ai * 128 + m * 16) * DM + col0;
#pragma unroll
                for (int bj = 0; bj < 2; ++bj)
#pragma unroll
                    for (int n = 0; n < 2; ++n) { const pg8::f32x4 bs = *(const pg8::f32x4*)(bp + off + bj * 128 + n * 16);
                        *(pg8::f32x4*)(op + off + bj * 128 + n * 16) = bs + gv[bj][n] * acc[ai][bj][m][n]; } }
    }
};
__device__ __forceinline__ float silu_f(float x) { return x * __builtin_amdgcn_rcpf(1.0f + __expf(-x)); }
struct EpiSwiGLU {
    static constexpr bool PERM = true, AFTER_DRAIN = false;
    pg8::bf16_t* O;
    __device__ __forceinline__ void operator()(const pg8::f32x4 (&acc)[2][2][4][2], const pg8::Unit& u, int wr, int wc, int fr, int fq) const {
        const int row0 = u.pm * 256 + wr * 64 + fr, col0 = u.pn * 128 + wc * 32 + 8 * fq;
#pragma unroll
        for (int ai = 0; ai < 2; ++ai)
#pragma unroll
            for (int m = 0; m < 4; ++m) { pg8::bf16_t* rowp = O + (size_t)(row0 + ai * 128 + m * 16) * FFNH + col0;
                const pg8::f32x4 g0 = acc[ai][0][m][0], g1 = acc[ai][0][m][1], u0 = acc[ai][1][m][0], u1 = acc[ai][1][m][1];
                pg8::u32x4 w;
                w.x = pk2(silu_f(g0[0]) * u0[0], silu_f(g0[1]) * u0[1]); w.y = pk2(silu_f(g0[2]) * u0[2], silu_f(g0[3]) * u0[3]);
                w.z = pk2(silu_f(g1[0]) * u1[0], silu_f(g1[1]) * u1[1]); w.w = pk2(silu_f(g1[2]) * u1[2], silu_f(g1[3]) * u1[3]);
                *(pg8::u32x4*)rowp = w; }
    }
};
struct Args {
    const float* in[32]; float* out; unsigned char* ws;
};
struct Frame {
    LAS unsigned char* lds; int tid, lane, wave, G, bid;
    int gtid, gthreads, gwave, gwaves;
};
__device__ __forceinline__ float wave_sum(float v) {
#pragma unroll
    for (int o = 1; o < 64; o <<= 1) v += __shfl_xor(v, o);
    return v;
}
__device__ __forceinline__ int vec_of_row(int row) { return row < NCTX ? 0 : 1 + ((row - NCTX) >> 10); }
__device__ __forceinline__ float sigmoid_f(float x) { return 1.0f / (1.0f + __expf(-x)); }

__device__ __forceinline__ void transpose_item(const float* W, int K, int N, bf16* WT, int k0, int n0, int drow0, LAS float* scr, int lane) {
#pragma unroll 8
    for (int i = 0; i < 32; ++i) { const int kk = 2 * i + (lane >> 5); scr[kk * 33 + (lane & 31)] = W[(size_t)(k0 + kk) * N + n0 + (lane & 31)]; }
    LDS_WAIT(); asm volatile("" ::: "memory");
    const int c = lane & 7;
#pragma unroll
    for (int j = 0; j < 4; ++j) { const int n = (lane >> 3) + 8 * j; const LAS float* s = scr + (8 * c) * 33 + n;
        v4u o; o.x = pk2(s[0 * 33], s[1 * 33]); o.y = pk2(s[2 * 33], s[3 * 33]); o.z = pk2(s[4 * 33], s[5 * 33]); o.w = pk2(s[6 * 33], s[7 * 33]);
        *(GAS v4u*)(WT + (size_t)(drow0 + n) * K + k0 + 8 * c) = o; }
    LDS_WAIT(); asm volatile("" ::: "memory");
}

__device__ __forceinline__ void phase_prologue(const Frame& F, const Args& A) {
    LAS float* cs = (LAS float*)F.lds;
    for (int i = F.tid; i < 5 * DM; i += 512) { const int v = i / DM, k = i % DM; const float x = v == 0 ? A.in[10][k] : A.in[9][(v - 1) * DM + k]; cs[i] = x * sigmoid_f(x); }
    __syncthreads();
    float* modp = (float*)(A.ws + WS_MODP);
    for (int it = F.bid; it < 2 * KSPLIT * 24; it += F.G) {
        const int l = it / (KSPLIT * 24), r = it % (KSPLIT * 24), ks = r / 24, nc = r % 24;
        const int n = nc * 512 + F.tid, kb = ks * (DM / KSPLIT);
        const float* w = A.in[13] + (size_t)l * DM * MODW + (size_t)kb * MODW + n;
        float a0 = 0.f, a1 = 0.f, a2 = 0.f, a3 = 0.f, a4 = 0.f;
#pragma unroll 8
        for (int k = 0; k < DM / KSPLIT; ++k) { const float wv = w[(size_t)k * MODW];
            a0 += cs[0 * DM + kb + k] * wv; a1 += cs[1 * DM + kb + k] * wv; a2 += cs[2 * DM + kb + k] * wv; a3 += cs[3 * DM + kb + k] * wv; a4 += cs[4 * DM + kb + k] * wv; }
        float* o = modp + ((size_t)(l * KSPLIT + ks) * 5) * MODW + n;
        o[0 * MODW] = a0; o[1 * MODW] = a1; o[2 * MODW] = a2; o[3 * MODW] = a3; o[4 * MODW] = a4;
    }
    __syncthreads();
    LAS float* scr = (LAS float*)(F.lds + F.wave * 16384);
    constexpr int I_IN = 32 * (PROJW / 32), I_OUT = 32 * (DM / 32), I_G = 32 * (FFNH / 32), I_D = (FFNH / 64) * (DM / 32);
    constexpr int I_L = I_IN + I_OUT + 2 * I_G + I_D;
    for (int it = F.gwave; it < 2 * I_L; it += F.gwaves) {
        const int l = it / I_L; int r = it % I_L;
        if (r < I_IN) { const int nb = PROJW / 32, kb = r / nb, n0 = 32 * (r % nb);
            transpose_item(A.in[15] + (size_t)l * DM * PROJW, DM, PROJW, (bf16*)(A.ws + WS_WIN) + (size_t)l * PROJW * DM, 64 * kb, n0, n0, scr, F.lane); continue; } r -= I_IN;
        if (r < I_OUT) { const int nb = DM / 32, kb = r / nb, n0 = 32 * (r % nb);
            transpose_item(A.in[16] + (size_t)l * DM * DM, DM, DM, (bf16*)(A.ws + WS_WOUT) + (size_t)l * DM * DM, 64 * kb, n0, n0, scr, F.lane); continue; } r -= I_OUT;
        if (r < 2 * I_G) { const int up = r >= I_G; if (up) r -= I_G; const int nb = FFNH / 32, kb = r / nb, n0 = 32 * (r % nb);
            transpose_item(A.in[up ? 30 : 29] + (size_t)l * DM * FFNH, DM, FFNH, (bf16*)(A.ws + WS_WGU) + (size_t)l * 2 * FFNH * DM, 64 * kb, n0, 256 * (n0 / 128) + (n0 % 128) + (up ? 128 : 0), scr, F.lane); continue; } r -= 2 * I_G;
        { const int nb = DM / 32, kb = r / nb, n0 = 32 * (r % nb);
            transpose_item(A.in[31] + (size_t)l * FFNH * DM, FFNH, DM, (bf16*)(A.ws + WS_WDN) + (size_t)l * DM * FFNH, 64 * kb, n0, n0, scr, F.lane); }
    }
}
__device__ __forceinline__ void phase_modfinal(const Frame& F, const Args& A) {
    const float* modp = (const float*)(A.ws + WS_MODP); float* modv = (float*)(A.ws + WS_MODV);
    for (int i = F.gtid; i < 2 * 5 * MODW; i += F.gthreads) {
        const int l = i / (5 * MODW), r = i % (5 * MODW), n = r % MODW;
        float s = A.in[14][l * MODW + n];
#pragma unroll
        for (int ks = 0; ks < KSPLIT; ++ks) s += modp[(size_t)(l * KSPLIT + ks) * 5 * MODW + r];
        modv[i] = s;
    }
}
__device__ __forceinline__ void phase_modnorm(const Frame& F, const Args& A, int l, int which) {
    const float* modv = (const float*)(A.ws + WS_MODV) + (size_t)l * 5 * MODW;
    const float* g = A.in[which ? 12 : 11] + l * DM;
    bf16* H = (bf16*)(A.ws + WS_H);
    const bool from_in = (l == 0 && which == 0);
    for (int row = F.gwave; row < NTOK; row += F.gwaves) {
        const float* xr = from_in ? (row < NCTX ? A.in[0] + (size_t)row * DM : A.in[1] + (size_t)(row - NCTX) * DM) : A.out + O_Y + (size_t)row * DM;
        const int v = vec_of_row(row);
        const float* sh = modv + (size_t)v * MODW + (which ? 3 : 0) * DM; const float* sc = sh + DM;
        f32x4 x[8]; float ss = 0.f;
#pragma unroll
        for (int j = 0; j < 8; ++j) { x[j] = *(const f32x4*)(xr + 4 * F.lane + 256 * j); ss += (x[j].x * x[j].x + x[j].y * x[j].y) + (x[j].z * x[j].z + x[j].w * x[j].w); }
        const float rs = rsqrtf(wave_sum(ss) * (1.0f / DM) + 1e-6f);
#pragma unroll
        for (int j = 0; j < 8; ++j) { const int c = 4 * F.lane + 256 * j;
            const f32x4 gg = *(const f32x4*)(g + c), s1 = *(const f32x4*)(sc + c), s0 = *(const f32x4*)(sh + c);
            const f32x4 y = (x[j] * rs) * gg * (s1 + 1.0f) + s0;
            *(unsigned long long*)(H + (size_t)row * DM + c) = (unsigned long long)pk2(y.x, y.y) | ((unsigned long long)pk2(y.z, y.w) << 32); }
    }
}
__device__ __forceinline__ void phase_headnorm(const Frame& F, const Args& A, int l) {
    float* P = (float*)(A.ws + WS_P); float* U = (float*)(A.ws + WS_U);
    const float* gain = A.in[17] + l * 384;
    const int d = F.lane;
    const float invf = __powf(10000.0f, -(float)(d & 15) / 16.0f);
    for (int row = F.gwave; row < NTOK; row += F.gwaves) {
        float* pr = P + (size_t)row * PROJW;
        const bool lat = row >= NCTX; const int t = (row - NCTX) & 1023;
        float cs = 1.f, sn = 0.f;
        if (lat) { const float pos = (d >> 5) ? (float)(t & 63) : (float)(t >> 6); const float ang = pos * invf; cs = cosf(ang); sn = sinf(ang); }
        const int b = row >> 8, s = row & 255;
        for (int c = 0; c < 60; ++c) {
            float x = pr[c * 64 + d];
            int gi = -1; bool rope = false; float* o = nullptr; int ow = 0, oc = 0;
            if (c < 8) { gi = 0; rope = true; }
            else if (c < 10) { gi = 1; rope = true; o = A.out + O_SWAK; ow = 128; oc = c - 8; }
            else if (c < 12) { o = A.out + O_SWAV; ow = 128; oc = c - 10; }
            else if (c < 20) { gi = 2; }
            else if (c < 28) { gi = 3; o = A.out + O_NAK; ow = 512; oc = c - 20; }
            else if (c < 36) { o = A.out + O_NAV; ow = 512; oc = c - 28; }
            else if (c < 44) { gi = 4; rope = true; }
            else if (c < 52) { gi = 5; rope = true; o = A.out + O_DFK; ow = 512; oc = c - 44; }
            else { o = A.out + O_DFV; ow = 512; oc = c - 52; }
            if (gi >= 0) { const float ss = wave_sum(x * x) * (1.0f / 64.0f); x = x * rsqrtf(ss + 1e-6f) * gain[gi * 64 + d]; }
            if (rope && lat) { const float xp = __shfl_xor(x, 16); x = (d & 16) ? (x * cs + xp * sn) : (x * cs - xp * sn); }
            if (gi >= 0) pr[c * 64 + d] = x;
            if (!lat && o) o[((size_t)(b * 2 + l) * 256 + s) * ow + oc * 64 + d] = x;
        }
        const int T = lat ? 1024 : 256, tt = lat ? t : s;
        const float* cw = A.in[22] + l * 2048; const float* cb = A.in[23] + l * 512;
#pragma unroll
        for (int j = 0; j < 8; ++j) { const int ch = d + 64 * j; float acc = cb[ch];
#pragma unroll
            for (int tap = 0; tap < 4; ++tap) { const int t2 = tt + tap - 2; if (t2 >= 0 && t2 < T) acc += cw[tap * 512 + ch] * pr[(ptrdiff_t)(tap - 2) * PROJW + C_LX + ch]; }
            U[(size_t)row * 512 + ch] = acc; }
    }
}
template <int DV> struct OnlineSM {
    float m, l; float o[DV];
    __device__ __forceinline__ void init() { m = -1e30f; l = 0.f;
#pragma unroll
        for (int e = 0; e < DV; ++e) o[e] = 0.f; }
    __device__ __forceinline__ void add(float s, const float* v) {
        const float mn = fmaxf(m, s), sc = __expf(m - mn), p = __expf(s - mn); l = l * sc + p; m = mn;
#pragma unroll
        for (int e = 0; e < DV; e += 4) { const f32x4 vv = *(const f32x4*)(v + e); o[e] = o[e] * sc + p * vv.x; o[e + 1] = o[e + 1] * sc + p * vv.y; o[e + 2] = o[e + 2] * sc + p * vv.z; o[e + 3] = o[e + 3] * sc + p * vv.w; }
    }
    __device__ __forceinline__ void add_sink(float s) {
        const float mn = fmaxf(m, s), sc = __expf(m - mn), p = __expf(s - mn); l = l * sc + p; m = mn;
#pragma unroll
        for (int e = 0; e < DV; ++e) o[e] *= sc; }
};
__device__ __forceinline__ float dot64(const float (&q)[64], const float* k) {
    float s = 0.f;
#pragma unroll
    for (int e = 0; e < 64; e += 4) { const f32x4 kv = *(const f32x4*)(k + e); s += q[e] * kv.x + q[e + 1] * kv.y + q[e + 2] * kv.z + q[e + 3] * kv.w; }
    return s;
}
__device__ __forceinline__ void phase_mixA_diff(const Frame& F, const Args& A, int l) {
    const float* P = (const float*)(A.ws + WS_P); bf16* MIX = (bf16*)(A.ws + WS_MIX); float* DT = (float*)(A.ws + WS_DT);
    for (int it = F.gtid; it < 6 * 32768; it += F.gthreads) {
        const int type = it >> 15, sub = (it >> 12) & 7, rl = it & 4095;
        const int rl0 = rl & ~63;
        if (type == 0 || type == 3) {
            const bool lat = type == 0; const int row = lat ? NCTX + rl : rl; const int h = sub >> 1;
            float q[64];
#pragma unroll
            for (int e = 0; e < 64; e += 4) { const f32x4 t4 = *(const f32x4*)(P + (size_t)row * PROJW + C_DQ + sub * 64 + e); q[e] = t4.x * 0.125f; q[e + 1] = t4.y * 0.125f; q[e + 2] = t4.z * 0.125f; q[e + 3] = t4.w * 0.125f; }
            OnlineSM<128> sm; sm.init();
            const int b = lat ? (rl >> 10) : (rl >> 8); const int T = lat ? 1024 : 256; const int kr0 = lat ? NCTX + b * 1024 : b * 256;
            for (int j = 0; j < T; ++j) { const float* kp = P + (size_t)(kr0 + j) * PROJW; sm.add(dot64(q, kp + C_DK + sub * 64), kp + C_DV + h * 128); }
            if (lat) { const float* ck = A.in[6] + (size_t)(b * 2 + l) * 256 * 512; const float* cv = A.in[7] + (size_t)(b * 2 + l) * 256 * 512;
                for (int s = 0; s < 256; ++s) sm.add(dot64(q, ck + s * 512 + sub * 64), cv + s * 512 + h * 128); }
            const float il = 1.0f / sm.l; float* o = DT + (size_t)row * 1024 + sub * 128;
#pragma unroll
            for (int e = 0; e < 128; e += 4) *(f32x4*)(o + e) = (f32x4){sm.o[e] * il, sm.o[e + 1] * il, sm.o[e + 2] * il, sm.o[e + 3] * il};
        }
    }
}
__device__ __forceinline__ void phase_mixA_h64(const Frame& F, const Args& A, int l) {
    const float* P = (const float*)(A.ws + WS_P); bf16* MIX = (bf16*)(A.ws + WS_MIX); float* DT = (float*)(A.ws + WS_DT);
    for (int it = F.gtid; it < 6 * 32768; it += F.gthreads) {
        const int type = it >> 15, sub = (it >> 12) & 7, rl = it & 4095;
        const int rl0 = rl & ~63;
        if (type != 0 && type != 3) {
            const bool lat = type < 3; const bool na = (type == 1 || type == 4); const int row = lat ? NCTX + rl : rl; const int h = sub;
            const int qc = na ? C_NQ + h * 64 : C_SQ + h * 64, kc = na ? C_NK + h * 64 : C_SK + (h >> 2) * 64, vc = na ? C_NV + h * 64 : C_SV + (h >> 2) * 64;
            float q[64];
#pragma unroll
            for (int e = 0; e < 64; e += 4) { const f32x4 t4 = *(const f32x4*)(P + (size_t)row * PROJW + qc + e); q[e] = t4.x * 0.125f; q[e + 1] = t4.y * 0.125f; q[e + 2] = t4.z * 0.125f; q[e + 3] = t4.w * 0.125f; }
            OnlineSM<64> sm; sm.init();
            if (!lat) { const int b = rl >> 8; for (int j = 0; j < 256; ++j) { const float* kp = P + (size_t)(b * 256 + j) * PROJW; sm.add(dot64(q, kp + kc), kp + vc); } }
            else {
                const int b = rl >> 10, t = rl & 1023, t0 = rl0 & 1023; const int kr0 = NCTX + b * 1024;
                if (!na) {
                    const int j0 = t0 - 128 < 0 ? 0 : t0 - 128, j1 = t0 + 63 + 128 > 1023 ? 1023 : t0 + 63 + 128;
                    for (int j = j0; j <= j1; ++j) { const float* kp = P + (size_t)(kr0 + j) * PROJW; const float s = dot64(q, kp + kc); const int dd = t - j; if (dd <= 128 && dd >= -128) sm.add(s, kp + vc); }
                    const float* ck = A.in[2] + (size_t)(b * 2 + l) * 256 * 128; const float* cv = A.in[3] + (size_t)(b * 2 + l) * 256 * 128;
                    for (int s = 0; s < 256; ++s) sm.add(dot64(q, ck + s * 128 + (h >> 2) * 64), cv + s * 128 + (h >> 2) * 64);
                } else {
                    const int r = t >> 6, cq = t & 63; int krow0 = r - 4; krow0 = krow0 < 0 ? 0 : (krow0 > 8 ? 8 : krow0); int cst = cq - 8; cst = cst < 0 ? 0 : (cst > 48 ? 48 : cst);
                    const float* rpb = A.in[19] + (size_t)(l * 8 + h) * 15 * 31;
                    for (int i = 0; i < 8; ++i) for (int kcq = 0; kcq < 64; ++kcq) { const int kr = krow0 + i; const float* kp = P + (size_t)(kr0 + kr * 64 + kcq) * PROJW; const float s = dot64(q, kp + kc);
                        if (kcq >= cst && kcq < cst + 16) sm.add(s + rpb[(kr - r + 7) * 31 + (kcq - cq + 15)], kp + vc); }
                    const float* ck = A.in[4] + (size_t)(b * 2 + l) * 256 * 512; const float* cv = A.in[5] + (size_t)(b * 2 + l) * 256 * 512;
                    for (int s = 0; s < 256; ++s) sm.add(dot64(q, ck + s * 512 + h * 64), cv + s * 512 + h * 64);
                }
            }
            if (!na) sm.add_sink(A.in[18][l * 8 + h]);
            const float il = 1.0f / sm.l; bf16* o = MIX + (size_t)row * DM + (na ? 512 : 0) + h * 64;
#pragma unroll
            for (int e = 0; e < 64; e += 4) *(unsigned long long*)(o + e) = (unsigned long long)pk2(sm.o[e] * il, sm.o[e + 1] * il) | ((unsigned long long)pk2(sm.o[e + 2] * il, sm.o[e + 3] * il) << 32);
        }
    }
}
__device__ __forceinline__ void phase_gates(const Frame& F, const Args& A, int l) {
    const float* U = (const float*)(A.ws + WS_U); float* AB = (float*)(A.ws + WS_AB);
    for (int it = F.gtid; it < NTOK * 512; it += F.gthreads) {
        const int row = it >> 9, ch = it & 511, blk = ch >> 6, dd = ch & 63;
        const float* ur = U + (size_t)row * 512 + blk * 64; const float uown = ur[dd];
#pragma unroll
        for (int dir = 0; dir < 2; ++dir) {
            const float* wa = A.in[24] + ((size_t)((l * 2 + dir) * 8 + blk) * 64) * 64 + dd; const float* wx = A.in[26] + ((size_t)((l * 2 + dir) * 8 + blk) * 64) * 64 + dd;
            float ra = A.in[25][(l * 2 + dir) * 512 + ch], ri = A.in[27][(l * 2 + dir) * 512 + ch];
#pragma unroll 8
            for (int c = 0; c < 64; ++c) { const float uv = ur[c]; ra += uv * wa[c * 64]; ri += uv * wx[c * 64]; }
            const float r = sigmoid_f(ra), ii = sigmoid_f(ri);
            const float L = A.in[28][(l * 2 + dir) * 512 + ch]; const float sp = log1pf(__expf(-L));
            const float la = -8.0f * r * sp; const float a = __expf(la); const float bxv = sqrtf(-expm1f(2.0f * la)) * (ii * uown);
            AB[((size_t)dir * NTOK + row) * 512 + ch] = a; AB[((size_t)(2 + dir) * NTOK + row) * 512 + ch] = bxv;
        }
    }
}
__device__ __forceinline__ void phase_mixB(const Frame& F, const Args& A, int l) {
    const float* AB = (const float*)(A.ws + WS_AB); float* HS = (float*)(A.ws + WS_HS);
    for (int it = F.gtid; it < 20 * 2 * 512; it += F.gthreads) {
        const int ch = it & 511, dir = (it >> 9) & 1, seq = it >> 10;
        const bool lat = seq >= 16; const int T = lat ? 1024 : 256; const int r0 = lat ? NCTX + (seq - 16) * 1024 : seq * 256;
        float h = lat ? A.in[8][((size_t)((seq - 16) * 2 + l) * 2 + dir) * 512 + ch] : 0.f;
        const float* ap = AB + ((size_t)dir * NTOK + r0) * 512 + ch; const float* bp = AB + ((size_t)(2 + dir) * NTOK + r0) * 512 + ch; float* hp = HS + ((size_t)dir * NTOK + r0) * 512 + ch;
        if (dir == 0) {
#pragma unroll 8
            for (int t = 0; t < T; ++t) { h = ap[(size_t)t * 512] * h + bp[(size_t)t * 512]; hp[(size_t)t * 512] = h; }
        } else {
#pragma unroll 8
            for (int t = T - 1; t >= 0; --t) { h = ap[(size_t)t * 512] * h + bp[(size_t)t * 512]; hp[(size_t)t * 512] = h; }
        }
        if (!lat) A.out[O_LRU + ((size_t)(seq * 2 + l) * 2 + dir) * 512 + ch] = h;
    }
    const float* DT = (const float*)(A.ws + WS_DT); bf16* MIX = (bf16*)(A.ws + WS_MIX);
    const float* lp = A.in[20] + l * 256;
    const float s1 = wave_sum(lp[F.lane] * lp[64 + F.lane]), s2 = wave_sum(lp[128 + F.lane] * lp[192 + F.lane]);
    const float lam_init = 0.8f - 0.6f * expf(-0.3f * (float)l);
    const float lam = expf(s1) - expf(s2) + lam_init;
    const float* sub = A.in[21] + l * 128;
    for (int it = F.gwave; it < NTOK * 4; it += F.gwaves) {
        const int row = it >> 2, h = it & 3;
        const float* o0 = DT + (size_t)row * 1024 + (h * 2) * 128; const float* o1 = o0 + 128;
        const float x0 = o0[F.lane] - lam * o1[F.lane], x1 = o0[64 + F.lane] - lam * o1[64 + F.lane];
        const float rs = rsqrtf(wave_sum(x0 * x0 + x1 * x1) * (1.0f / 128.0f) + 1e-6f) * (1.0f - lam_init);
        bf16* o = MIX + (size_t)row * DM + 1024 + h * 128;
        o[F.lane] = (bf16)f2bf(x0 * rs * sub[F.lane]); o[64 + F.lane] = (bf16)f2bf(x1 * rs * sub[64 + F.lane]);
    }
}
__device__ __forceinline__ float gelu_tanh(float x) { const float u = 0.7978845608028654f * (x + 0.044715f * x * x * x); return 0.5f * x * (1.0f + tanhf(u)); }
__device__ __forceinline__ void phase_mixC(const Frame& F, const Args& A, int l) {
    const float* HS = (const float*)(A.ws + WS_HS); const float* P = (const float*)(A.ws + WS_P); bf16* MIX = (bf16*)(A.ws + WS_MIX);
    for (int it = F.gtid; it < NTOK * 512; it += F.gthreads) {
        const int row = it >> 9, ch = it & 511;
        const float y = (HS[(size_t)row * 512 + ch] + HS[((size_t)NTOK + row) * 512 + ch]) * gelu_tanh(P[(size_t)row * PROJW + C_LG + ch]);
        MIX[(size_t)row * DM + 1536 + ch] = (bf16)f2bf(y);
    }
}

template <int KIND> __global__ void __launch_bounds__(NWAVES * 64, 2) fwd_kernel(Args args, int l) {
    extern __shared__ __attribute__((aligned(16))) unsigned char lds[];
    Frame F;
    F.lds = (LAS unsigned char*)lds;
    F.tid = threadIdx.x; F.lane = F.tid & 63; F.wave = __builtin_amdgcn_readfirstlane(F.tid >> 6);
    F.G = gridDim.x; F.bid = blockIdx.x;
    F.gtid = F.bid * 512 + F.tid; F.gthreads = F.G * 512; F.gwave = F.bid * NWAVES + F.wave; F.gwaves = F.G * NWAVES;
    PG8_LAS unsigned char* ring = (PG8_LAS unsigned char*)lds;
    const float* modv = (const float*)(args.ws + WS_MODV) + (size_t)l * 5 * MODW;
    if constexpr (KIND == 0) phase_prologue(F, args);
    if constexpr (KIND == 1) phase_modfinal(F, args);
    if constexpr (KIND == 2) phase_modnorm(F, args, l, 0);
    if constexpr (KIND == 3) {
        pg8::Gemm g{(const pg8::bf16_t*)(args.ws + WS_H), (const pg8::bf16_t*)(args.ws + WS_WIN) + (size_t)l * PROJW * DM, NTOK, PROJW, DM};
        pg8::StaticOrder S; S.init(NTOK, PROJW, F.G, F.bid);
        EpiF32P E{(float*)(args.ws + WS_P), PROJW};
        pg8::gemm_phase<EpiF32P, pg8::StaticOrder, true, true>(ring, g, S, E);
    }
    if constexpr (KIND == 4) phase_headnorm(F, args, l);
    if constexpr (KIND == 5) phase_mixA_diff(F, args, l);
    if constexpr (KIND == 6) phase_mixA_h64(F, args, l);
    if constexpr (KIND == 7) phase_gates(F, args, l);
    if constexpr (KIND == 8) phase_mixB(F, args, l);
    if constexpr (KIND == 9) phase_mixC(F, args, l);
    if constexpr (KIND == 10) {
        pg8::Gemm g{(const pg8::bf16_t*)(args.ws + WS_MIX), (const pg8::bf16_t*)(args.ws + WS_WOUT) + (size_t)l * DM * DM, NTOK, DM, DM};
        pg8::StaticOrder S; S.init(NTOK, DM, F.G, F.bid);
        EpiResid E{l == 0 ? args.in[0] : args.out + O_Y, l == 0 ? args.in[1] : args.out + O_Y + (size_t)NCTX * DM, args.out + O_Y, modv + 2 * DM};
        pg8::gemm_phase<EpiResid, pg8::StaticOrder, true, true>(ring, g, S, E);
    }
    if constexpr (KIND == 11) phase_modnorm(F, args, l, 1);
    if constexpr (KIND == 12) {
        pg8::Gemm g{(const pg8::bf16_t*)(args.ws + WS_H), (const pg8::bf16_t*)(args.ws + WS_WGU) + (size_t)l * 2 * FFNH * DM, NTOK, 2 * FFNH, DM};
        pg8::StaticOrder S; S.init(NTOK, 2 * FFNH, F.G, F.bid);
        EpiSwiGLU E{(pg8::bf16_t*)(args.ws + WS_HM)};
        pg8::gemm_phase<EpiSwiGLU, pg8::StaticOrder, true, true>(ring, g, S, E);
    }
    if constexpr (KIND == 13) {
        pg8::Gemm g{(const pg8::bf16_t*)(args.ws + WS_HM), (const pg8::bf16_t*)(args.ws + WS_WDN) + (size_t)l * DM * FFNH, NTOK, DM, FFNH};
        pg8::StaticOrder S; S.init(NTOK, DM, F.G, F.bid);
        EpiResid E{args.out + O_Y, args.out + O_Y + (size_t)NCTX * DM, args.out + O_Y, modv + 5 * DM};
        pg8::gemm_phase<EpiResid, pg8::StaticOrder, true, true>(ring, g, S, E);
    }
}

template <int KIND> static bool prep() { return hipFuncSetAttribute((const void*)fwd_kernel<KIND>, hipFuncAttributeMaxDynamicSharedMemorySize, LDS_BYTES) == hipSuccess; }
template <int KIND> static void launch(const Args& a, int l, int grid, hipStream_t stream) { hipLaunchKernelGGL(fwd_kernel<KIND>, dim3(grid), dim3(NWAVES * 64), LDS_BYTES, stream, a, l); }
extern "C" void kernel_launch(void* const* d_in, const int* in_sizes, int n_in, void* d_out, int out_size, void* d_ws, size_t ws_size, hipStream_t stream) {
    static int grid = 0;
    if (grid == 0) {
        if (n_in != 32 || out_size != 35684352 || ws_size < WS_END) { fprintf(stderr, "kernel_launch: unexpected shapes n_in %d out %d ws %zu\n", n_in, out_size, ws_size); grid = -1; return; }
        int dev = 0, cus = 0;
        if (hipGetDevice(&dev) != hipSuccess || hipDeviceGetAttribute(&cus, hipDeviceAttributeMultiprocessorCount, dev) != hipSuccess) { grid = -1; return; }
        bool ok = prep<0>() && prep<1>() && prep<2>() && prep<3>() && prep<4>() && prep<5>() && prep<6>() && prep<7>() && prep<8>() && prep<9>() && prep<10>() && prep<11>() && prep<12>() && prep<13>();
        if (!ok) { fprintf(stderr, "kernel_launch: hipFuncSetAttribute failed\n"); grid = -1; return; }
        grid = cus;
    }
    if (grid < 0) return;
    Args a{};
    for (int i = 0; i < 32; ++i) a.in[i] = (const float*)d_in[i];
    a.out = (float*)d_out; a.ws = (unsigned char*)d_ws;
    launch<0>(a, 0, grid, stream); launch<1>(a, 0, grid, stream);
    for (int l = 0; l < 2; ++l) {
        launch<2>(a, l, grid, stream); launch<3>(a, l, grid, stream); launch<4>(a, l, grid, stream); launch<5>(a, l, grid, stream); launch<6>(a, l, grid, stream); launch<7>(a, l, grid, stream);
        launch<8>(a, l, grid, stream); launch<9>(a, l, grid, stream); launch<10>(a, l, grid, stream); launch<11>(a, l, grid, stream); launch<12>(a, l, grid, stream); launch<13>(a, l, grid, stream);
    }
}
```

```cpp
#include <hip/hip_runtime.h>
#include <cstdio>
#include <cstdint>
#include <cstddef>
namespace pg8 {
#define PG8_LAS __attribute__((address_space(3)))
typedef unsigned short bf16_t;
typedef short bf16x8 __attribute__((ext_vector_type(8)));
typedef float f32x4 __attribute__((ext_vector_type(4)));
typedef unsigned u32x4 __attribute__((ext_vector_type(4)));
constexpr int BM = 256, BK = 64, HALF = 128, HTB = HALF * BK * 2  , STAGE_BYTES = 8 * HTB, NXCD = 8, WGM = 8;

__host__ __device__ __forceinline__ int lds_byte(int r, int c) { return (r >> 3) * 1024 + (r & 7) * 128 + (((c >> 3) ^ ((r >> 1) & 7)) * 16) + (c & 7) * 2; }
__host__ __device__ __forceinline__ void stage_rc(int b, int& R, int& C) { const int st = b >> 10, p = b & 1023; R = st * 8 + (p >> 7); C = ((((p >> 4) & 7) ^ ((R >> 1) & 7)) * 8) + ((p & 15) >> 1); }
__host__ __device__ __forceinline__ int perm32(int rho) { const int n = rho >> 4, i = rho & 15; return 8 * (i >> 2) + 4 * n + (i & 3); }

struct Unit { int pm, pn; };
struct Gemm { const bf16_t* A; const bf16_t* Bt; int M, N, K; };

struct StaticOrder {
    int nM, nN, nwg, G, c;
    __host__ __device__ void init(int M, int N, int G_, int c_) { nM = M / BM; nN = N / BM; nwg = nM * nN; G = G_; c = c_; }
    __host__ __device__ bool next(int i, Unit& u) const {
        const long L = (long)i * G + c; if (L >= nwg) return false;
        int wgid = (int)L; { const int q = nwg / NXCD, r = nwg % NXCD, xcd = wgid % NXCD, off = wgid / NXCD; wgid = (xcd < r ? xcd * (q + 1) : r * (q + 1) + (xcd - r) * q) + off; }
        const int nig = WGM * nN, gid = wgid / nig, fm = gid * WGM, gsz = (nM - fm) < WGM ? (nM - fm) : WGM;
        u.pm = fm + ((wgid % nig) % gsz); u.pn = (wgid % nig) / gsz; return true;
    }
    __device__ __forceinline__ void a_ready(const Unit&) const {}
    __device__ __forceinline__ void done(const Unit&) const {}
};

__device__ __forceinline__ unsigned cvt_pk_bf16(float lo, float hi) { unsigned r; asm volatile("v_cvt_pk_bf16_f32 %0, %1, %2" : "=v"(r) : "v"(lo), "v"(hi)); return r; }
template <class Epi, class Sched, bool ALIGN_EPI = false, bool SP2 = false>
__device__ __forceinline__ void gemm_phase(PG8_LAS unsigned char* lds, const Gemm g, const Sched& S, const Epi& E) {
    int tid_ = threadIdx.x; asm volatile("" : "+v"(tid_)); const int tid = tid_, wid = __builtin_amdgcn_readfirstlane(tid >> 6), lane = tid & 63, wr = wid >> 2, wc = wid & 3, fr = lane & 15, fq = lane >> 4;
    const int K = g.K, nt = K / BK;
    unsigned voffA[2], voffB[2];
#pragma unroll
    for (int i = 0; i < 2; ++i) { int R, C; stage_rc(tid * 16 + i * 8192, R, C); const int Rb = Epi::PERM ? ((R & ~31) + perm32(R & 31)) : R;
        voffA[i] = (unsigned)(R * K + C) * 2u; voffB[i] = (unsigned)(Rb * K + C) * 2u; }
    const size_t kstep = (size_t)(BK * 2);
    const size_t hstep = (size_t)HALF * K * 2;
    const size_t tstep = 2 * hstep;
    const unsigned ldsw = (unsigned)wid * 1024u;
    const int aoffk[2] = {lds_byte(wr * 64 + fr, fq * 8), lds_byte(wr * 64 + fr, 32 + fq * 8)}, boffk[2] = {lds_byte(wc * 32 + fr, fq * 8), lds_byte(wc * 32 + fr, 32 + fq * 8)};
#define PG8_SA(b, h) (((b) * 2 + (h)) * HTB)
#define PG8_SB(b, h) ((4 + (b) * 2 + (h)) * HTB)
#define PG8_STAGE(bufoff, gbase, voff) do { _Pragma("unroll") for (int _i = 0; _i < 2; ++_i) \
        __builtin_amdgcn_global_load_lds((const unsigned*)((const char*)(gbase) + (voff)[_i]), (PG8_LAS unsigned*)(lds + (bufoff) + ldsw + _i * 8192), 16, 0, 0); } while (0)
#define PG8_LDA(dst, b, h) do { _Pragma("unroll") for (int m = 0; m < 4; ++m) _Pragma("unroll") for (int k = 0; k < 2; ++k) dst[m][k] = *(const PG8_LAS bf16x8*)(lds + PG8_SA(b, h) + aoffk[k] + m * 2048); } while (0)
#define PG8_LDB(dst, b, h) do { _Pragma("unroll") for (int n = 0; n < 2; ++n) _Pragma("unroll") for (int k = 0; k < 2; ++k) dst[n][k] = *(const PG8_LAS bf16x8*)(lds + PG8_SB(b, h) + boffk[k] + n * 2048); } while (0)
#define PG8_MMA(ai, bj, At, Bt) do { __builtin_amdgcn_s_setprio(1); _Pragma("unroll") for (int m = 0; m < 4; ++m) _Pragma("unroll") for (int n = 0; n < 2; ++n) _Pragma("unroll") for (int k = 0; k < 2; ++k) \
        acc[ai][bj][m][n] = __builtin_amdgcn_mfma_f32_16x16x32_bf16(Bt[n][k], At[m][k], acc[ai][bj][m][n], 0, 0, 0); __builtin_amdgcn_s_setprio(0); } while (0)
#define PG8_WAIT_V(n) asm volatile("s_waitcnt vmcnt(" #n ")" ::: "memory")
#define PG8_WAIT_L(n) asm volatile("s_waitcnt lgkmcnt(" #n ")" ::: "memory")
#define PG8_BAR __builtin_amdgcn_s_barrier()
#define PG8_SCHED __builtin_amdgcn_sched_barrier(0)
    Unit cur, nxt; int ui = 0;
    if (!S.next(0, cur)) return;
    f32x4 acc[2][2][4][2];
#pragma unroll
    for (int a = 0; a < 2; ++a)
#pragma unroll
        for (int b = 0; b < 2; ++b)
#pragma unroll
            for (int m = 0; m < 4; ++m)
#pragma unroll
                for (int n = 0; n < 2; ++n) acc[a][b][m][n] = (f32x4){0.f, 0.f, 0.f, 0.f};
    bf16x8 At[4][2], B0[2][2], B1[2][2];
    const char* cA = (const char*)g.A + (size_t)cur.pm * tstep; const char* cB = (const char*)g.Bt + (size_t)cur.pn * tstep;
    S.a_ready(cur);
    if constexpr (SP2) {
        PG8_STAGE(PG8_SB(0, 0), cB, voffB); PG8_STAGE(PG8_SB(0, 1), cB + hstep, voffB); PG8_STAGE(PG8_SA(0, 0), cA, voffA); PG8_STAGE(PG8_SA(0, 1), cA + hstep, voffA);
        if (wr == 1) PG8_BAR;
        PG8_WAIT_V(2); PG8_BAR;
        PG8_STAGE(PG8_SB(1, 0), cB + kstep, voffB); PG8_STAGE(PG8_SA(1, 0), cA + kstep, voffA); PG8_STAGE(PG8_SB(1, 1), cB + hstep + kstep, voffB);
        PG8_WAIT_V(6); PG8_BAR;
    } else {
        PG8_STAGE(PG8_SB(0, 0), cB, voffB); PG8_STAGE(PG8_SA(0, 0), cA, voffA); PG8_STAGE(PG8_SB(0, 1), cB + hstep, voffB); PG8_STAGE(PG8_SA(0, 1), cA + hstep, voffA);
        if (wr == 1) PG8_BAR;
        PG8_WAIT_V(4); PG8_BAR;
        PG8_STAGE(PG8_SB(1, 0), cB + kstep, voffB); PG8_STAGE(PG8_SA(1, 0), cA + kstep, voffA); PG8_STAGE(PG8_SB(1, 1), cB + hstep + kstep, voffB);
        PG8_WAIT_V(6); PG8_BAR;
    }
    for (;;) {
        const bool has_next = S.next(ui + 1, nxt);
        const char* nA = has_next ? (const char*)g.A + (size_t)nxt.pm * tstep : cA; const char* nB = has_next ? (const char*)g.Bt + (size_t)nxt.pn * tstep : cB;
        for (int t = 0; t < nt; t += 2) {
            const bool last = (t == nt - 2);
            const char* a1 = cA + (size_t)(t + 1) * kstep;
            const char* a2 = last ? nA : cA + (size_t)(t + 2) * kstep; const char* b2 = last ? nB : cB + (size_t)(t + 2) * kstep;
            const char* a3 = a2 + kstep; const char* b3 = b2 + kstep;
            if (last && has_next) S.a_ready(nxt);
            if constexpr (SP2) {
            PG8_LDB(B0, 0, 0); PG8_LDB(B1, 0, 1); PG8_SCHED; PG8_LDA(At, 0, 0); PG8_STAGE(PG8_SA(1, 1), a1 + hstep, voffA);
            PG8_WAIT_V(8); PG8_WAIT_L(0); PG8_BAR; PG8_MMA(0, 0, At, B0); PG8_MMA(0, 1, At, B1); PG8_BAR; PG8_SCHED;
            PG8_LDA(At, 0, 1); PG8_STAGE(PG8_SB(0, 0), b2, voffB); PG8_STAGE(PG8_SB(0, 1), b2 + hstep, voffB); PG8_STAGE(PG8_SA(0, 0), a2, voffA);
            PG8_WAIT_V(8); PG8_WAIT_L(0); PG8_BAR; PG8_MMA(1, 0, At, B0); PG8_MMA(1, 1, At, B1); PG8_BAR; PG8_SCHED;
            PG8_LDB(B0, 1, 0); PG8_LDB(B1, 1, 1); PG8_SCHED; PG8_LDA(At, 1, 0); PG8_STAGE(PG8_SA(0, 1), a2 + hstep, voffA);
            PG8_WAIT_V(8); PG8_WAIT_L(0); PG8_BAR; PG8_MMA(0, 0, At, B0); PG8_MMA(0, 1, At, B1); PG8_BAR; PG8_SCHED;
            PG8_LDA(At, 1, 1); PG8_STAGE(PG8_SB(1, 0), b3, voffB); PG8_STAGE(PG8_SB(1, 1), b3 + hstep, voffB); PG8_STAGE(PG8_SA(1, 0), a3, voffA);
            PG8_WAIT_V(8); PG8_WAIT_L(0); PG8_BAR; PG8_MMA(1, 0, At, B0); PG8_MMA(1, 1, At, B1); PG8_BAR; PG8_SCHED;
            } else {
            PG8_LDB(B0, 0, 0); PG8_SCHED; PG8_LDA(At, 0, 0); PG8_STAGE(PG8_SA(1, 1), a1 + hstep, voffA);
            PG8_WAIT_L(8); PG8_BAR; PG8_WAIT_L(0); PG8_MMA(0, 0, At, B0); PG8_BAR; PG8_SCHED;
            PG8_LDB(B1, 0, 1); PG8_STAGE(PG8_SB(0, 0), b2, voffB);
            PG8_BAR; PG8_WAIT_L(0); PG8_MMA(0, 1, At, B1); PG8_BAR;
            PG8_LDA(At, 0, 1); PG8_STAGE(PG8_SA(0, 0), a2, voffA);
            PG8_BAR; PG8_WAIT_L(0); PG8_MMA(1, 0, At, B0); PG8_BAR; PG8_SCHED;
            PG8_STAGE(PG8_SB(0, 1), b2 + hstep, voffB);
            PG8_WAIT_V(6); PG8_BAR; PG8_MMA(1, 1, At, B1); PG8_BAR;
            PG8_LDB(B0, 1, 0); PG8_SCHED; PG8_LDA(At, 1, 0); PG8_STAGE(PG8_SA(0, 1), a2 + hstep, voffA);
            PG8_WAIT_L(8); PG8_BAR; PG8_WAIT_L(0); PG8_MMA(0, 0, At, B0); PG8_BAR; PG8_SCHED;
            PG8_LDB(B1, 1, 1); PG8_STAGE(PG8_SB(1, 0), b3, voffB);
            PG8_BAR; PG8_WAIT_L(0); PG8_MMA(0, 1, At, B1); PG8_BAR;
            PG8_LDA(At, 1, 1); PG8_STAGE(PG8_SA(1, 0), a3, voffA);
            PG8_BAR; PG8_WAIT_L(0); PG8_MMA(1, 0, At, B0); PG8_BAR; PG8_SCHED;
            PG8_STAGE(PG8_SB(1, 1), b3 + hstep, voffB);
            PG8_WAIT_V(6); PG8_BAR; PG8_MMA(1, 1, At, B1); PG8_BAR;
            }
        }
        if constexpr (ALIGN_EPI) { if (wr == 0) PG8_BAR; }
        if constexpr (!Epi::AFTER_DRAIN) { E(acc, cur, wr, wc, fr, fq); S.done(cur); }
        if (!has_next) break;
#pragma unroll
        for (int a = 0; a < 2; ++a)
#pragma unroll
            for (int b = 0; b < 2; ++b)
#pragma unroll
                for (int m = 0; m < 4; ++m)
#pragma unroll
                    for (int n = 0; n < 2; ++n) acc[a][b][m][n] = (f32x4){0.f, 0.f, 0.f, 0.f};
        cur = nxt; cA = nA; cB = nB; ++ui;
        if constexpr (ALIGN_EPI) { if (wr == 1) PG8_BAR; }
    }
    PG8_WAIT_V(0);
    if constexpr (!ALIGN_EPI) { if (wr == 0) PG8_BAR; }
    PG8_BAR;
    if constexpr (Epi::AFTER_DRAIN) { E.fused(acc, cur, wr, wc, fr, fq, lds, wid, lane); S.done(cur); }
#undef PG8_SA
#undef PG8_SB
#undef PG8_STAGE
#undef PG8_LDA
#undef PG8_LDB
#undef PG8_MMA
#undef PG8_WAIT_V
#undef PG8_WAIT_L
#undef PG8_BAR
#undef PG8_SCHED
}
}
#define GAS __attribute__((address_space(1)))
#define LAS __attribute__((address_space(3)))
typedef unsigned short bf16;
typedef unsigned v4u __attribute__((ext_vector_type(4)));
typedef float f32x4 __attribute__((ext_vector_type(4)));
typedef short bf16x8 __attribute__((ext_vector_type(8)));
typedef GAS unsigned gu32;
typedef GAS unsigned long long gu64;
#define RLX_AGENT __ATOMIC_RELAXED, __HIP_MEMORY_SCOPE_AGENT
#define LDS_WAIT() asm volatile("s_waitcnt lgkmcnt(0)" ::: "memory")
#define VM_WAIT() asm volatile("s_waitcnt vmcnt(0)" ::: "memory")
__device__ __forceinline__ unsigned long long rt() { return __builtin_amdgcn_s_memrealtime(); }
__device__ __forceinline__ unsigned pk2(float lo, float hi) { unsigned r; asm("v_cvt_pk_bf16_f32 %0, %1, %2" : "=v"(r) : "v"(lo), "v"(hi)); return r; }
__device__ __forceinline__ unsigned f2bf(float f) { return pk2(f, 0.f) & 0xffffu; }

#define XB_TMO      128
#define XB_XCNT(j)  (256  + 64 * (j))
#define XB_XSUB(j)  (1280 + 64 * (j))
#define XB_XGEN(j)  (2304 + 64 * (j))
#define XB_TOP      3328
#define XB_TOPGEN   3392
#define XCD_BAR_WORDS 3456
#define XB_SPIN_CAP (1u << 18)

__device__ __forceinline__ unsigned xb_ld(unsigned* p)              { return __hip_atomic_load(p, __ATOMIC_RELAXED, __HIP_MEMORY_SCOPE_AGENT); }
__device__ __forceinline__ unsigned xb_add(unsigned* p, unsigned v) { return __hip_atomic_fetch_add(p, v, __ATOMIC_RELAXED, __HIP_MEMORY_SCOPE_AGENT); }
__device__ __forceinline__ unsigned xb_xcc_id() { return (unsigned)__builtin_amdgcn_s_getreg((3 << 11) | 20) & 0xFu; }
#define XB_SPIN(cond, bar) do { unsigned _sp = 0; while (cond) { __builtin_amdgcn_s_sleep(1); \
    if ((++_sp & 255u) == 0u) { if (xb_ld(&(bar)[XB_TMO])) break; if (_sp > XB_SPIN_CAP) { atomicAdd(&(bar)[XB_TMO], 1u); break; } } } } while (0)

struct XcdBarrier {
    unsigned* bar; unsigned x;
    volatile LAS unsigned* st;
};

__device__ __forceinline__ XcdBarrier xcd_barrier_post(unsigned* bar, volatile LAS unsigned* st) {
    XcdBarrier b; b.bar = bar; b.x = xb_xcc_id(); b.st = st;
    if (threadIdx.x == 0) (void)xb_add(&bar[XB_XCNT(b.x)], 1u);
    return b;
}
__device__ __forceinline__ void xcd_barrier_complete(unsigned* bar, unsigned x, unsigned& nloc, unsigned& nx) {
    const unsigned G = gridDim.x * gridDim.y * gridDim.z;
    unsigned sum, cnt, mine, sp = 0u;
    for (;;) {
        sum = 0u; cnt = 0u; mine = 0u;
#pragma unroll
        for (unsigned j = 0; j < 16; ++j) { const unsigned c = xb_ld(&bar[XB_XCNT(j)]); sum += c; cnt += (c > 0u) ? 1u : 0u; mine = (j == x) ? c : mine; }
        if (sum == G) break;
        __builtin_amdgcn_s_sleep(1);
        if ((++sp & 255u) == 0u) { if (xb_ld(&bar[XB_TMO])) break; if (sp > XB_SPIN_CAP) { atomicAdd(&bar[XB_TMO], 1u); break; } }
    }
    nloc = mine > 0u ? mine : 1u; nx = cnt > 0u ? cnt : 1u;
}

__device__ __forceinline__ void xcd_barrier(const XcdBarrier& b) {
    asm volatile("s_waitcnt vmcnt(0)" ::: "memory");
    __syncthreads();
    if (threadIdx.x == 0) {
        unsigned* bar = b.bar;
        __builtin_amdgcn_s_waitcnt(0);
        unsigned nloc = b.st[0], nx = b.st[1];
        if (nloc == 0u) { xcd_barrier_complete(bar, b.x, nloc, nx); b.st[0] = nloc; b.st[1] = nx; }
        const unsigned old = xb_add(&bar[XB_XSUB(b.x)], 1u);
        const unsigned gen = old / nloc;
        if (old + 1u == (gen + 1u) * nloc) {
            __builtin_amdgcn_fence(__ATOMIC_RELEASE, "agent");
            asm volatile("s_waitcnt vmcnt(0)" ::: "memory");
            const unsigned og = xb_add(&bar[XB_TOP], 1u);
            const unsigned tg = og / nx;
            if (og + 1u == (tg + 1u) * nx) xb_add(&bar[XB_TOPGEN], 1u);
            else XB_SPIN(xb_ld(&bar[XB_TOPGEN]) == tg, bar);
            __builtin_amdgcn_fence(__ATOMIC_ACQUIRE, "agent");
            xb_add(&bar[XB_XGEN(b.x)], 1u);
            asm volatile("s_waitcnt vmcnt(0)" ::: "memory");
        } else {
            XB_SPIN(xb_ld(&bar[XB_XGEN(b.x)]) == gen, bar);
            __builtin_amdgcn_fence(__ATOMIC_ACQUIRE, "agent");
            asm volatile("s_waitcnt vmcnt(0)" ::: "memory");
        }
    }
    __syncthreads();
}
constexpr int DM = 2048, NTOK = 8192, NCTX = 4096, PROJW = 4864, FFNH = 5632, MODW = 12288;
constexpr int C_SQ = 0, C_SK = 512, C_SV = 640, C_NQ = 768, C_NK = 1280, C_NV = 1792, C_DQ = 2304, C_DK = 2816, C_DV = 3328, C_LX = 3840, C_LG = 4352;
constexpr size_t O_Y = 0, O_SWAK = 16777216, O_SWAV = 17825792, O_NAK = 18874368, O_NAV = 23068672, O_DFK = 27262976, O_DFV = 31457280, O_LRU = 35651584;
constexpr size_t MiB = 1u << 20;
constexpr size_t WS_CTL = 0, CTL_ZERO_BYTES = 65536;
constexpr int KSPLIT = 16;
constexpr size_t WS_MODP = 2 * MiB;
constexpr size_t WS_MODV = 10 * MiB;
constexpr size_t WS_ROPE = 11 * MiB;
constexpr size_t WS_WIN = 12 * MiB;
constexpr size_t WS_WOUT = 52 * MiB;
constexpr size_t WS_WGU = 68 * MiB;
constexpr size_t WS_WDN = 156 * MiB;
constexpr size_t WS_H = 200 * MiB;
constexpr size_t WS_MIX = 232 * MiB;
constexpr size_t WS_HM = 264 * MiB;
constexpr size_t WS_QKF = 352 * MiB;
constexpr size_t WS_U = 504 * MiB;
constexpr size_t WS_AB = 420 * MiB;
constexpr size_t WS_LW = 520 * MiB;
constexpr size_t WS_HS = 584 * MiB;
constexpr size_t WS_PB = 616 * MiB;
constexpr size_t WS_VT = 692 * MiB;
constexpr size_t WS_CKB = 712 * MiB;
constexpr size_t WS_CVT = 717 * MiB;
constexpr size_t WS_END = 722 * MiB;
constexpr int CW_BAR = 4096;

constexpr int NWAVES = 8;
constexpr int RING_BYTES = 131072, LDSCTL_OFF = RING_BYTES, MISC_OFF = LDSCTL_OFF + 320, LDS_BYTES = 147456;

__device__ __forceinline__ float bf2f(unsigned short b) { return __builtin_bit_cast(float, (unsigned)b << 16); }

struct EpiF32P {
    static constexpr bool PERM = false, AFTER_DRAIN = false;
    float* C; int ldc;
    __device__ __forceinline__ void operator()(const pg8::f32x4 (&acc)[2][2][4][2], const pg8::Unit& u, int wr, int wc, int fr, int fq) const {
        const int row0 = u.pm * 256 + wr * 64 + fr, col0 = u.pn * 256 + wc * 32 + 4 * fq;
#pragma unroll
        for (int ai = 0; ai < 2; ++ai)
#pragma unroll
            for (int m = 0; m < 4; ++m) { float* rowp = C + (size_t)(row0 + ai * 128 + m * 16) * ldc + col0;
#pragma unroll
                for (int bj = 0; bj < 2; ++bj)
#pragma unroll
                    for (int n = 0; n < 2; ++n) *(pg8::f32x4*)(rowp + bj * 128 + n * 16) = acc[ai][bj][m][n]; }
    }
};
struct EpiResid {
    static constexpr bool PERM = false, AFTER_DRAIN = false;
    const float* b0; const float* b1; float* out; const float* gate;
    __device__ __forceinline__ void operator()(const pg8::f32x4 (&acc)[2][2][4][2], const pg8::Unit& u, int wr, int wc, int fr, int fq) const {
        const int v = u.pm < 16 ? 0 : 1 + ((u.pm - 16) >> 2);
        const float* bp = u.pm < 16 ? b0 + (size_t)u.pm * 256 * DM : b1 + (size_t)(u.pm - 16) * 256 * DM;
        float* op = out + (size_t)u.pm * 256 * DM;
        const int r0 = wr * 64 + fr, col0 = u.pn * 256 + wc * 32 + 4 * fq;
        pg8::f32x4 gv[2][2];
#pragma unroll
        for (int bj = 0; bj < 2; ++bj)
#pragma unroll
            for (int n = 0; n < 2; ++n) gv[bj][n] = *(const pg8::f32x4*)(gate + (size_t)v * MODW + col0 + bj * 128 + n * 16);
#pragma unroll
        for (int ai = 0; ai < 2; ++ai)
#pragma unroll
            for (int mp = 0; mp < 2; ++mp) {
                pg8::f32x4 bs[2][2][2];
#pragma unroll
                for (int mm = 0; mm < 2; ++mm) { const size_t off = (size_t)(r0 + ai * 128 + (2 * mp + mm) * 16) * DM + col0;
#pragma unroll
                    for (int bj = 0; bj < 2; ++bj)
#pragma unroll
                        for (int n = 0; n < 2; ++n) bs[mm][bj][n] = *(const pg8::f32x4*)(bp + off + bj * 128 + n * 16); }
#pragma unroll
                for (int mm = 0; mm < 2; ++mm) { const size_t off = (size_t)(r0 + ai * 128 + (2 * mp + mm) * 16) * DM + col0;
#pragma unroll
                    for (int bj = 0; bj < 2; ++bj)
#pragma unroll
                        for (int n = 0; n < 2; ++n) *(pg8::f32x4*)(op + off + bj * 128 + n * 16) = bs[mm][bj][n] + gv[bj][n] * acc[ai][bj][2 * mp + mm][n]; }
            }
    }
};
__device__ __forceinline__ float silu_f(float x) { return x * __builtin_amdgcn_rcpf(1.0f + __expf(-x)); }
struct EpiSwiGLU {
    static constexpr bool PERM = true, AFTER_DRAIN = false;
    pg8::bf16_t* O;
    __device__ __forceinline__ void operator()(const pg8::f32x4 (&acc)[2][2][4][2], const pg8::Unit& u, int wr, int wc, int fr, int fq) const {
        const int row0 = u.pm * 256 + wr * 64 + fr, col0 = u.pn * 128 + wc * 32 + 8 * fq;
#pragma unroll
        for (int ai = 0; ai < 2; ++ai)
#pragma unroll
            for (int m = 0; m < 4; ++m) { pg8::bf16_t* rowp = O + (size_t)(row0 + ai * 128 + m * 16) * FFNH + col0;
                const pg8::f32x4 g0 = acc[ai][0][m][0], g1 = acc[ai][0][m][1], u0 = acc[ai][1][m][0], u1 = acc[ai][1][m][1];
                pg8::u32x4 w;
                w.x = pk2(silu_f(g0[0]) * u0[0], silu_f(g0[1]) * u0[1]); w.y = pk2(silu_f(g0[2]) * u0[2], silu_f(g0[3]) * u0[3]);
                w.z = pk2(silu_f(g1[0]) * u1[0], silu_f(g1[1]) * u1[1]); w.w = pk2(silu_f(g1[2]) * u1[2], silu_f(g1[3]) * u1[3]);
                *(pg8::u32x4*)rowp = w; }
    }
};
struct Args {
    const float* in[32]; float* out; unsigned char* ws; int ph_lo, ph_hi; unsigned probe; unsigned pad;
};
typedef const __attribute__((address_space(4))) Args* KArgs;
struct Frame {
    LAS unsigned char* lds; int tid, lane, wave, G, bid;
    int gtid, gthreads, gwave, gwaves;
};
__device__ __forceinline__ float wave_sum(float v) {
#pragma unroll
    for (int o = 1; o < 64; o <<= 1) v += __shfl_xor(v, o);
    return v;
}
__host__ __device__ __forceinline__ int proj_slot(int a) { const int wc = a >> 6, d = a & 63; return 128 * ((d >> 4) & 1) + 32 * wc + 16 * ((d >> 2) & 1) + 4 * (2 * (d >> 5) + ((d >> 3) & 1)) + (d & 3); }
__device__ __forceinline__ int vt_pos(int t) { const int x = t & 15; return (t & ~15) + 8 * ((x >> 2) & 1) + 4 * ((x >> 3) & 1) + (x & 3); }
__device__ __forceinline__ int vec_of_row(int row) { return row < NCTX ? 0 : 1 + ((row - NCTX) >> 10); }
__device__ __forceinline__ float sigmoid_f(float x) { return 1.0f / (1.0f + __expf(-x)); }

__device__ __forceinline__ void transpose_item(const float* W, int K, int N, bf16* WT, int k0, int n0, int drow0, LAS float* scr, int lane, bool perm = false) {
#pragma unroll 8
    for (int i = 0; i < 32; ++i) { const int kk = 2 * i + (lane >> 5); scr[kk * 33 + (lane & 31)] = W[(size_t)(k0 + kk) * N + n0 + (lane & 31)]; }
    LDS_WAIT(); asm volatile("" ::: "memory");
    const int c = lane & 7;
#pragma unroll
    for (int j = 0; j < 4; ++j) { const int n = (lane >> 3) + 8 * j; const LAS float* s = scr + (8 * c) * 33 + n;
        v4u o; o.x = pk2(s[0 * 33], s[1 * 33]); o.y = pk2(s[2 * 33], s[3 * 33]); o.z = pk2(s[4 * 33], s[5 * 33]); o.w = pk2(s[6 * 33], s[7 * 33]);
        const int dr = perm ? ((n0 + n) & ~255) + proj_slot((n0 + n) & 255) : drow0 + n;
        *(GAS v4u*)(WT + (size_t)dr * K + k0 + 8 * c) = o; }
    LDS_WAIT(); asm volatile("" ::: "memory");
}

__device__ __forceinline__ void phase_prologue(const Frame& F, KArgs A) {
    LAS float* cs = (LAS float*)F.lds;
    for (int i = F.tid; i < 5 * DM; i += 512) { const int v = i / DM, k = i % DM; const float x = v == 0 ? A->in[10][k] : A->in[9][(v - 1) * DM + k]; cs[i] = x * sigmoid_f(x); }
    __syncthreads();
    float* modp = (float*)(A->ws + WS_MODP);
    for (int it = F.bid; it < 2 * KSPLIT * 24; it += F.G) {
        const int l = it / (KSPLIT * 24), r = it % (KSPLIT * 24), ks = r / 24, nc = r % 24;
        const int n = nc * 512 + F.tid, kb = ks * (DM / KSPLIT);
        const float* w = A->in[13] + (size_t)l * DM * MODW + (size_t)kb * MODW + n;
        float a0 = 0.f, a1 = 0.f, a2 = 0.f, a3 = 0.f, a4 = 0.f;
#pragma unroll 8
        for (int k = 0; k < DM / KSPLIT; ++k) { const float wv = w[(size_t)k * MODW];
            a0 += cs[0 * DM + kb + k] * wv; a1 += cs[1 * DM + kb + k] * wv; a2 += cs[2 * DM + kb + k] * wv; a3 += cs[3 * DM + kb + k] * wv; a4 += cs[4 * DM + kb + k] * wv; }
        float* o = modp + ((size_t)(l * KSPLIT + ks) * 5) * MODW + n;
        o[0 * MODW] = a0; o[1 * MODW] = a1; o[2 * MODW] = a2; o[3 * MODW] = a3; o[4 * MODW] = a4;
    }
    __syncthreads();
    {
        constexpr int S_IN = (DM / 256) * (PROJW / 128), S_OUT = (DM / 256) * (DM / 128), S_G = (DM / 256) * (FFNH / 128), S_D = (FFNH / 256) * (DM / 128);
        constexpr int S_L = S_IN + S_OUT + 2 * S_G + S_D;
        const int hr = F.lane >> 5, p = F.lane & 31, w = F.wave;
        for (int it = F.bid; it < 2 * S_L; it += F.G) {
            const int l = it / S_L; int r = it % S_L;
            const float* W; bf16* WT; int K, N, k0, n0, drow0; bool perm = false;
            if (r < S_IN) { const int nb = PROJW / 128; W = A->in[15] + (size_t)l * DM * PROJW; WT = (bf16*)(A->ws + WS_WIN) + (size_t)l * PROJW * DM; K = DM; N = PROJW; k0 = 256 * (r / nb); n0 = 128 * (r % nb); drow0 = n0; perm = true; }
            else if ((r -= S_IN) < S_OUT) { const int nb = DM / 128; W = A->in[16] + (size_t)l * DM * DM; WT = (bf16*)(A->ws + WS_WOUT) + (size_t)l * DM * DM; K = DM; N = DM; k0 = 256 * (r / nb); n0 = 128 * (r % nb); drow0 = n0; }
            else if ((r -= S_OUT) < 2 * S_G) { const int up = r >= S_G; if (up) r -= S_G; const int nb = FFNH / 128; W = A->in[up ? 30 : 29] + (size_t)l * DM * FFNH; WT = (bf16*)(A->ws + WS_WGU) + (size_t)l * 2 * FFNH * DM;
                K = DM; N = FFNH; k0 = 256 * (r / nb); n0 = 128 * (r % nb); drow0 = 256 * (n0 / 128) + (up ? 128 : 0); }
            else { r -= 2 * S_G; const int nb = DM / 128; W = A->in[31] + (size_t)l * FFNH * DM; WT = (bf16*)(A->ws + WS_WDN) + (size_t)l * DM * FFNH; K = FFNH; N = DM; k0 = 256 * (r / nb); n0 = 128 * (r % nb); drow0 = n0; }
            const float* src = W + (size_t)(k0 + 32 * w + hr) * N + n0;
#pragma unroll
            for (int i = 0; i < 16; ++i)
                __builtin_amdgcn_global_load_lds((const unsigned*)(src + (size_t)(2 * i) * N + 4 * (p ^ (4 * w + (i >> 2)))), (LAS unsigned*)(F.lds + (32 * w + 2 * i) * 512), 16, 0, 0);
            asm volatile("s_waitcnt vmcnt(0)" ::: "memory");
            __syncthreads();
            const LAS float* Lf = (const LAS float*)F.lds;
#pragma unroll
            for (int j = 0; j < 8; ++j) { const int n = 16 * w + 2 * j + hr; const LAS float* sp = Lf + (8 * p) * 128 + ((((n >> 2) ^ p) << 2) | (n & 3));
                v4u o; o.x = pk2(sp[0 * 128], sp[1 * 128]); o.y = pk2(sp[2 * 128], sp[3 * 128]); o.z = pk2(sp[4 * 128], sp[5 * 128]); o.w = pk2(sp[6 * 128], sp[7 * 128]);
                const int dr = perm ? ((n0 + n) & ~255) + proj_slot((n0 + n) & 255) : drow0 + n;
                *(GAS v4u*)(WT + (size_t)dr * K + k0 + 8 * p) = o; }
            __syncthreads();
        }
    }
    if (F.gtid < 1024) { const int pos = F.gtid >> 4, f = F.gtid & 15; const float ang = (float)pos * powf(10000.0f, -(float)f / 16.0f);
        float* rt = (float*)(A->ws + WS_ROPE); rt[F.gtid] = cosf(ang); rt[1024 + F.gtid] = sinf(ang); }
    { bf16* LW = (bf16*)(A->ws + WS_LW); constexpr int N = 2 * 2 * 2 * 8 * 64 * 64;
      for (int i0 = F.gtid; i0 < N; i0 += 4 * F.gthreads) {
          float v[4];
#pragma unroll
          for (int u = 0; u < 4; ++u) { const int i = i0 + u * F.gthreads; v[u] = 0.f;
              if (i < N) { const int c = i & 63, d = (i >> 6) & 63, blk = (i >> 12) & 7, mat = (i >> 15) & 1, ld = i >> 16; v[u] = A->in[mat ? 26 : 24][((size_t)(ld * 8 + blk) * 64 + c) * 64 + d]; } }
#pragma unroll
          for (int u = 0; u < 4; ++u) { const int i = i0 + u * F.gthreads; if (i < N) LW[i] = (bf16)f2bf(v[u]); }
      } }
    bf16* CKB = (bf16*)(A->ws + WS_CKB); bf16* CVT = (bf16*)(A->ws + WS_CVT);
    { constexpr int N = 2 * 4 * 256 * 144;
      for (int i0 = F.gtid; i0 < N; i0 += 3 * F.gthreads) {
          f32x4 v0[3], v1[3];
#pragma unroll
          for (int u = 0; u < 3; ++u) { const int i = i0 + u * F.gthreads; v0[u] = (f32x4){0.f, 0.f, 0.f, 0.f}; v1[u] = v0[u];
              if (i < N) { const int g = i % 144, r = i / 144, sk = r & 255, b = (r >> 8) & 3, l = r >> 10; const int col = 8 * g;
                  const size_t src = (size_t)(b * 2 + l) * 256 + sk;
                  const float* p = col < 128 ? A->in[2] + src * 128 + col : (col < 640 ? A->in[4] + src * 512 + col - 128 : A->in[6] + src * 512 + col - 640);
                  v0[u] = *(const f32x4*)p; v1[u] = *(const f32x4*)(p + 4); } }
#pragma unroll
          for (int u = 0; u < 3; ++u) { const int i = i0 + u * F.gthreads;
              if (i < N) { const int g = i % 144, r = i / 144, sk = r & 255, b = (r >> 8) & 3, l = r >> 10; const int col = 8 * g, cc = col >> 6, d = col & 63;
                  v4u o; o.x = pk2(v0[u].x, v0[u].y); o.y = pk2(v0[u].z, v0[u].w); o.z = pk2(v1[u].x, v1[u].y); o.w = pk2(v1[u].z, v1[u].w);
                  *(v4u*)(CKB + ((((size_t)(l * 4 + b) * 18 + cc) * 8 + (sk >> 5)) * 2048) + (d >> 4) * 512 + ((d >> 3) & 1) * 256 + (sk & 31) * 8) = o; } }
      } }
    { constexpr int N = 2 * 4 * 32 * 1152;
      for (int i0 = F.gtid; i0 < N; i0 += 3 * F.gthreads) {
          float v[3][8];
#pragma unroll
          for (int u = 0; u < 3; ++u) { const int i = i0 + u * F.gthreads;
#pragma unroll
              for (int j = 0; j < 8; ++j) v[u][j] = 0.f;
              if (i < N) { const int col = i % 1152, r = i / 1152, grp = r & 31, b = (r >> 5) & 3, l = r >> 7; const int t = grp >> 2, sp = (grp >> 1) & 1, hh = grp & 1;
                  const float* base; int stride;
                  if (col < 128) { base = A->in[3] + col; stride = 128; } else if (col < 640) { base = A->in[5] + col - 128; stride = 512; } else { base = A->in[7] + col - 640; stride = 512; }
                  base += (size_t)(b * 2 + l) * 256 * stride;
#pragma unroll
                  for (int j = 0; j < 8; ++j) { const int key = 32 * t + 16 * sp + 8 * (j >> 2) + 4 * hh + (j & 3); v[u][j] = base[(size_t)key * stride]; } } }
#pragma unroll
          for (int u = 0; u < 3; ++u) { const int i = i0 + u * F.gthreads;
              if (i < N) { const int col = i % 1152, r = i / 1152, grp = r & 31, b = (r >> 5) & 3, l = r >> 7; const int t = grp >> 2, sp = (grp >> 1) & 1, hh = grp & 1;
                  v4u o; o.x = pk2(v[u][0], v[u][1]); o.y = pk2(v[u][2], v[u][3]); o.z = pk2(v[u][4], v[u][5]); o.w = pk2(v[u][6], v[u][7]);
                  *(v4u*)(CVT + ((((size_t)(l * 4 + b) * 36 + (col >> 5)) * 8 + t) * 1024) + sp * 512 + hh * 256 + (col & 31) * 8) = o; } }
      } }
}
__device__ __forceinline__ void phase_modfinal(const Frame& F, KArgs A) {
    const float* modp = (const float*)(A->ws + WS_MODP); float* modv = (float*)(A->ws + WS_MODV);
    for (int i = F.gtid; i < 2 * 5 * MODW; i += F.gthreads) {
        const int l = i / (5 * MODW), r = i % (5 * MODW), n = r % MODW;
        float s = A->in[14][l * MODW + n];
#pragma unroll
        for (int ks = 0; ks < KSPLIT; ++ks) s += modp[(size_t)(l * KSPLIT + ks) * 5 * MODW + r];
        modv[i] = s;
    }
}
__device__ __forceinline__ void phase_modnorm(const Frame& F, KArgs A, int l, int which) {
    const float* modv = (const float*)(A->ws + WS_MODV) + (size_t)l * 5 * MODW;
    const float* g = A->in[which ? 12 : 11] + l * DM;
    bf16* H = (bf16*)(A->ws + WS_H);
    const bool from_in = (l == 0 && which == 0);
    LAS float* GS = (LAS float*)F.lds; LAS float* SH = GS + DM;
    for (int rb = F.bid; rb < NTOK / 32; rb += F.G) {
        const int rbase = rb * 32 + 4 * F.wave;
        { const int v = vec_of_row(rb * 32), c = 4 * F.tid;
          const float* sh = modv + (size_t)v * MODW + (which ? 3 : 0) * DM; const float* sc = sh + DM;
          const f32x4 gg = *(const f32x4*)(g + c); f32x4 s1, s0;
          if (from_in) {
              const float* mp = (const float*)(A->ws + WS_MODP) + (size_t)v * MODW + c;
              s0 = *(const f32x4*)(A->in[14] + c); s1 = *(const f32x4*)(A->in[14] + DM + c);
#pragma unroll
              for (int ks = 0; ks < KSPLIT; ++ks) { s0 += *(const f32x4*)(mp + (size_t)ks * 5 * MODW); s1 += *(const f32x4*)(mp + (size_t)ks * 5 * MODW + DM); }
          } else { s1 = *(const f32x4*)(sc + c); s0 = *(const f32x4*)(sh + c); }
          *(LAS f32x4*)(GS + c) = gg * (s1 + 1.0f); *(LAS f32x4*)(SH + c) = s0; }
        {
            f32x4 x[4][8]; float ss[4];
#pragma unroll
            for (int u = 0; u < 4; ++u) { const int row = rbase + u;
                const float* xr = from_in ? (row < NCTX ? A->in[0] + (size_t)row * DM : A->in[1] + (size_t)(row - NCTX) * DM) : A->out + O_Y + (size_t)row * DM;
#pragma unroll
                for (int j = 0; j < 8; ++j) x[u][j] = *(const f32x4*)(xr + 4 * F.lane + 256 * j); }
#pragma unroll
            for (int u = 0; u < 4; ++u) { ss[u] = 0.f;
#pragma unroll
                for (int j = 0; j < 8; ++j) ss[u] += (x[u][j].x * x[u][j].x + x[u][j].y * x[u][j].y) + (x[u][j].z * x[u][j].z + x[u][j].w * x[u][j].w); }
            __syncthreads();
#pragma unroll
            for (int u = 0; u < 4; ++u) { const int row = rbase + u;
                const float rs = rsqrtf(wave_sum(ss[u]) * (1.0f / DM) + 1e-6f);
#pragma unroll
                for (int j = 0; j < 8; ++j) { const int c = 4 * F.lane + 256 * j;
                    const f32x4 y = (x[u][j] * rs) * *(const LAS f32x4*)(GS + c) + *(const LAS f32x4*)(SH + c);
                    *(unsigned long long*)(H + (size_t)row * DM + c) = (unsigned long long)pk2(y.x, y.y) | ((unsigned long long)pk2(y.z, y.w) << 32); } }
        }
        __syncthreads();
    }
}
typedef float f32x16 __attribute__((ext_vector_type(16)));
typedef float f32x2 __attribute__((ext_vector_type(2)));
__device__ __forceinline__ unsigned cvtpk(float lo, float hi) { unsigned r; asm("v_cvt_pk_bf16_f32 %0, %1, %2" : "=v"(r) : "v"(lo), "v"(hi)); return r; }
__device__ __forceinline__ int crow(int r, int h) { return (r & 3) + 8 * (r >> 2) + 4 * h; }
constexpr float SM_SCALE = 0.125f * 1.4426950408889634f, LOG2E = 1.4426950408889634f;
template <int NDB, int MODE>
__device__ __forceinline__ void attn_seg(f32x16 (&o)[NDB], float& m, float& l, const bf16x8 (&qf)[4], const bf16* kb, const bf16* vb, int vdbs, int lo, int nt,
                                         int mq, int mk0, const LAS float* rpb, int h) {
    bf16x8 kf[4], kn[4];
#pragma unroll
    for (int ks = 0; ks < 4; ++ks) kf[ks] = *(const bf16x8*)(kb + ks * 512 + lo);
    for (int t = 0; t < nt; ++t) {
        const int tn = (t + 1 < nt) ? t + 1 : t;
#pragma unroll
        for (int ks = 0; ks < 4; ++ks) kn[ks] = *(const bf16x8*)(kb + (size_t)tn * 2048 + ks * 512 + lo);
        bf16x8 vf[2][NDB];
#pragma unroll
        for (int s = 0; s < 2; ++s)
#pragma unroll
            for (int db = 0; db < NDB; ++db) vf[s][db] = *(const bf16x8*)(vb + (size_t)db * vdbs + (size_t)t * 1024 + s * 512 + lo);
        f32x16 st = {0.f, 0.f, 0.f, 0.f, 0.f, 0.f, 0.f, 0.f, 0.f, 0.f, 0.f, 0.f, 0.f, 0.f, 0.f, 0.f};
#pragma unroll
        for (int ks = 0; ks < 4; ++ks) st = __builtin_amdgcn_mfma_f32_32x32x16_bf16(kf[ks], qf[ks], st, 0, 0, 0);
        float s[16];
        int mb = 0; const LAS float* rp = rpb;
        if (MODE == 1) mb = mq - mk0 - 4 * h - 32 * t + 128;
        if (MODE == 2) { int cst = mq - 8; cst = cst < 0 ? 0 : (cst > 48 ? 48 : cst); const int kcb = 32 * (t & 1) + 4 * h; mb = kcb - cst; rp = rpb + (mk0 + (t >> 1)) * 127 + (kcb - mq + 15 + 48); }
#pragma unroll
        for (int r = 0; r < 16; ++r) {
            const int cr = (r & 3) + 8 * (r >> 2);
            float v = st[r];
            if (MODE == 1) { if ((unsigned)(mb - cr) > 256u) v = -1e30f; }
            if (MODE == 2) { const bool ok = (unsigned)(mb + cr) < 16u; const float bias = rp[cr]; v = ok ? v + bias : -1e30f; }
            s[r] = v;
        }
        float mx = s[0];
#pragma unroll
        for (int r = 1; r < 16; ++r) mx = fmaxf(mx, s[r]);
        mx = fmaxf(mx, __shfl_xor(mx, 32));
        if (__any(mx > m)) {
            const float mn = fmaxf(m, mx), alpha = __builtin_amdgcn_exp2f(m - mn); m = mn; l *= alpha;
#pragma unroll
            for (int db = 0; db < NDB; ++db) o[db] = o[db] * alpha;
        }
        { const f32x2 mm = {m, m}; f32x2 acc2 = {0.f, 0.f};
#pragma unroll
          for (int r = 0; r < 16; r += 2) { f32x2 x = {s[r], s[r + 1]}; x = x - mm; x.x = __builtin_amdgcn_exp2f(x.x); x.y = __builtin_amdgcn_exp2f(x.y); acc2 += x; s[r] = x.x; s[r + 1] = x.y; }
          l += acc2.x + acc2.y; }
        v4u p0, p1;
        p0.x = cvtpk(s[0], s[1]); p0.y = cvtpk(s[2], s[3]); p0.z = cvtpk(s[4], s[5]); p0.w = cvtpk(s[6], s[7]);
        p1.x = cvtpk(s[8], s[9]); p1.y = cvtpk(s[10], s[11]); p1.z = cvtpk(s[12], s[13]); p1.w = cvtpk(s[14], s[15]);
        const bf16x8 pa0 = __builtin_bit_cast(bf16x8, p0), pa1 = __builtin_bit_cast(bf16x8, p1);
#pragma unroll
        for (int db = 0; db < NDB; ++db) { o[db] = __builtin_amdgcn_mfma_f32_32x32x16_bf16(vf[0][db], pa0, o[db], 0, 0, 0); o[db] = __builtin_amdgcn_mfma_f32_32x32x16_bf16(vf[1][db], pa1, o[db], 0, 0, 0); }
#pragma unroll
        for (int ks = 0; ks < 4; ++ks) kf[ks] = kn[ks];
    }
}
constexpr int COOP_STAGE = 16384, COOP_PARK = 65536;
__device__ __forceinline__ void attn_coop_unit(const Frame& F, KArgs A, int l, int unit) {
    const bf16* QKF = (const bf16*)(A->ws + WS_QKF); const bf16* VF = (const bf16*)(A->ws + WS_VT);
    const int b = unit >> 5, hd = (unit >> 3) & 3, qblk = unit & 7;
    const bf16* ckf = (const bf16*)(A->ws + WS_CKB) + (size_t)(l * 4 + b) * 18 * 8 * 2048; const bf16* cvf = (const bf16*)(A->ws + WS_CVT) + (size_t)(l * 4 + b) * 36 * 8 * 1024;
    bf16* MIX = (bf16*)(A->ws + WS_MIX);
    const int lane = F.lane, j = lane & 31, h = lane >> 5, lo = lane * 8, w = F.wave, ip = w >> 2;
    const int seq0 = NCTX + b * 1024, tile0 = seq0 >> 5, qtile = tile0 + qblk * 4 + (w & 3);
    auto src_piece = [&](int p, int t) -> const bf16* {
        if (p < 8) { const int c = 44 + 2 * hd + (p >> 2), ks = p & 3;
            return (t < 32 ? QKF + ((size_t)c * 256 + tile0 + t) * 2048 : ckf + ((size_t)(10 + 2 * hd + (p >> 2)) * 8 + (t - 32)) * 2048) + ks * 512 + lo; }
        const int db = (p - 8) >> 1, sh = (p - 8) & 1, vdb = 20 + 4 * hd + db;
        return (t < 32 ? VF + ((size_t)vdb * 256 + tile0 + t) * 1024 : cvf + ((size_t)vdb * 8 + (t - 32)) * 1024) + sh * 512 + lo; };
#define COOP_DMA(t, stage) do { _Pragma("unroll") for (int pp = 0; pp < 2; ++pp) { const int p_ = 2 * w + pp; \
        __builtin_amdgcn_global_load_lds((const unsigned*)src_piece(p_, (t)), (LAS unsigned*)(F.lds + (stage) * COOP_STAGE + p_ * 1024), 16, 0, 0); } } while (0)
    bf16x8 qf[4];
#pragma unroll
    for (int ks = 0; ks < 4; ++ks) qf[ks] = *(const bf16x8*)(QKF + ((size_t)(36 + 2 * hd + ip) * 256 + qtile) * 2048 + ks * 512 + lo);
    f32x16 o[4];
#pragma unroll
    for (int db = 0; db < 4; ++db) o[db] = (f32x16){0.f, 0.f, 0.f, 0.f, 0.f, 0.f, 0.f, 0.f, 0.f, 0.f, 0.f, 0.f, 0.f, 0.f, 0.f, 0.f};
    float m = -1e30f, lsum = 0.f;
#define COOP_DMA2(tp, stage) do { _Pragma("unroll") for (int u_ = 0; u_ < 2; ++u_) _Pragma("unroll") for (int pp = 0; pp < 2; ++pp) { const int p_ = 2 * w + pp; \
        __builtin_amdgcn_global_load_lds((const unsigned*)src_piece(p_, 2 * (tp) + u_), (LAS unsigned*)(F.lds + (stage) * 32768 + u_ * 16384 + p_ * 1024), 16, 0, 0); } } while (0)
    COOP_DMA2(0, 0);
    asm volatile("s_waitcnt vmcnt(0)" ::: "memory"); __syncthreads();
#pragma unroll 1
    for (int tp = 0; tp < 20; ++tp) {
        const int st_ = tp & 1;
        if (tp + 1 < 20) COOP_DMA2(tp + 1, st_ ^ 1);
        const LAS unsigned char* sb = F.lds + st_ * 32768;
        f32x16 st0 = {0.f, 0.f, 0.f, 0.f, 0.f, 0.f, 0.f, 0.f, 0.f, 0.f, 0.f, 0.f, 0.f, 0.f, 0.f, 0.f}, st1 = st0;
#pragma unroll
        for (int ks = 0; ks < 4; ++ks) { const bf16x8 k0 = *(const LAS bf16x8*)(sb + ip * 4096 + ks * 1024 + lane * 16), k1 = *(const LAS bf16x8*)(sb + 16384 + ip * 4096 + ks * 1024 + lane * 16);
            st0 = __builtin_amdgcn_mfma_f32_32x32x16_bf16(k0, qf[ks], st0, 0, 0, 0); st1 = __builtin_amdgcn_mfma_f32_32x32x16_bf16(k1, qf[ks], st1, 0, 0, 0); }
        float sc[32];
#pragma unroll
        for (int r = 0; r < 16; ++r) { sc[r] = st0[r]; sc[16 + r] = st1[r]; }
        float mx = fmaxf(sc[0], sc[16]);
#pragma unroll
        for (int r = 1; r < 16; ++r) mx = fmaxf(mx, fmaxf(sc[r], sc[16 + r]));
        mx = fmaxf(mx, __shfl_xor(mx, 32));
        if (__any(mx > m)) { const float mn = fmaxf(m, mx), alpha = __builtin_amdgcn_exp2f(m - mn); m = mn; lsum *= alpha;
#pragma unroll
            for (int db = 0; db < 4; ++db) o[db] = o[db] * alpha; }
        float ps0 = 0.f, ps1 = 0.f;
#pragma unroll
        for (int r = 0; r < 16; ++r) { sc[r] = __builtin_amdgcn_exp2f(sc[r] - m); ps0 += sc[r]; sc[16 + r] = __builtin_amdgcn_exp2f(sc[16 + r] - m); ps1 += sc[16 + r]; }
        lsum += ps0 + ps1;
#pragma unroll
        for (int u = 0; u < 2; ++u) {
            v4u p0, p1;
            p0.x = cvtpk(sc[16 * u + 0], sc[16 * u + 1]); p0.y = cvtpk(sc[16 * u + 2], sc[16 * u + 3]); p0.z = cvtpk(sc[16 * u + 4], sc[16 * u + 5]); p0.w = cvtpk(sc[16 * u + 6], sc[16 * u + 7]);
            p1.x = cvtpk(sc[16 * u + 8], sc[16 * u + 9]); p1.y = cvtpk(sc[16 * u + 10], sc[16 * u + 11]); p1.z = cvtpk(sc[16 * u + 12], sc[16 * u + 13]); p1.w = cvtpk(sc[16 * u + 14], sc[16 * u + 15]);
            const bf16x8 pa0 = __builtin_bit_cast(bf16x8, p0), pa1 = __builtin_bit_cast(bf16x8, p1);
#pragma unroll
            for (int db = 0; db < 4; ++db) { const bf16x8 v0 = *(const LAS bf16x8*)(sb + u * 16384 + 8192 + (db * 2) * 1024 + lane * 16), v1 = *(const LAS bf16x8*)(sb + u * 16384 + 8192 + (db * 2 + 1) * 1024 + lane * 16);
                o[db] = __builtin_amdgcn_mfma_f32_32x32x16_bf16(v0, pa0, o[db], 0, 0, 0); o[db] = __builtin_amdgcn_mfma_f32_32x32x16_bf16(v1, pa1, o[db], 0, 0, 0); }
        }
        asm volatile("s_waitcnt vmcnt(0)" ::: "memory"); __syncthreads();
    }
#undef COOP_DMA2
#undef COOP_DMA
    lsum += __shfl_xor(lsum, 32);
    const float il = 1.0f / lsum;
    LAS float* parkw = (LAS float*)(F.lds + COOP_PARK + (w & 3) * 16384) + lane;
    if (ip == 0) {
#pragma unroll
        for (int db = 0; db < 4; ++db)
#pragma unroll
            for (int r = 0; r < 16; ++r) parkw[(db * 16 + r) * 64] = o[db][r] * il;
    }
    __syncthreads();
    if (ip == 1) {
        const float* lp = A->in[20] + l * 256;
        const float s1 = wave_sum(lp[lane] * lp[64 + lane]), s2 = wave_sum(lp[128 + lane] * lp[192 + lane]);
        int lq_ = l; asm volatile("" : "+s"(lq_));
        const float lam_init = lq_ == 0 ? 0.2f : 0.35550906f; const float lam = expf(s1) - expf(s2) + lam_init;
        float ss = 0.f;
#pragma unroll
        for (int db = 0; db < 4; ++db)
#pragma unroll
            for (int r = 0; r < 16; ++r) { const float x = parkw[(db * 16 + r) * 64] - lam * (o[db][r] * il); o[db][r] = x; ss += x * x; }
        ss += __shfl_xor(ss, 32);
        const float rs = rsqrtf(ss * (1.0f / 128.0f) + 1e-6f) * (1.0f - lam_init);
        const float* sub = A->in[21] + l * 128;
        bf16* orow = MIX + (size_t)(seq0 + (qblk * 4 + (w & 3)) * 32 + j) * DM + 1024 + 128 * hd;
#pragma unroll
        for (int db = 0; db < 4; ++db)
#pragma unroll
            for (int g = 0; g < 4; ++g) { const int d = 32 * db + 8 * g + 4 * h; const f32x4 sv = *(const f32x4*)(sub + d);
                *(unsigned long long*)(orow + d) = (unsigned long long)cvtpk(o[db][4 * g] * rs * sv.x, o[db][4 * g + 1] * rs * sv.y) | ((unsigned long long)cvtpk(o[db][4 * g + 2] * rs * sv.z, o[db][4 * g + 3] * rs * sv.w) << 32); }
    }
    __syncthreads();
}
constexpr int CW_Q = 8192;
constexpr int N_ITEMS = 5120;
__device__ __forceinline__ void phase_attn(const Frame& F, KArgs A, int l, int rep) {
    const bf16* QKF = (const bf16*)(A->ws + WS_QKF); const bf16* VF = (const bf16*)(A->ws + WS_VT);
    const bf16* CKF = (const bf16*)(A->ws + WS_CKB) + (size_t)l * 4 * 18 * 8 * 2048; const bf16* CVF = (const bf16*)(A->ws + WS_CVT) + (size_t)l * 4 * 36 * 8 * 1024;
    bf16* MIX = (bf16*)(A->ws + WS_MIX);
    const int lane = F.lane, j = lane & 31, h = lane >> 5;
    const float* lp = A->in[20] + l * 256;
    const float s1 = wave_sum(lp[lane] * lp[64 + lane]), s2 = wave_sum(lp[128 + lane] * lp[192 + lane]);
    int ll_ = l; asm volatile("" : "+s"(ll_));
    const float lam_init = ll_ == 0 ? 0.2f : 0.35550906f;
    const float lam = expf(s1) - expf(s2) + lam_init;
    unsigned* ctr = (unsigned*)(A->ws + WS_CTL) + CW_Q + ((rep * 2 + l) * 8 + (F.bid & 7)) * 64;
    LAS float* park = (LAS float*)(F.lds + F.wave * 16384) + lane;
    if (F.bid >= 32 && F.bid < 160) { const int i_ = (F.bid - 32) >> 3, grp = (F.bid & 7) * 2 + (i_ >> 3); attn_coop_unit(F, A, l, grp * 8 + (i_ & 7)); }
    const bool paired = false; const int ip = 0; volatile LAS unsigned* flagA = nullptr; volatile LAS unsigned* flagB = nullptr; const unsigned tag = 0u;
    for (;;) {
        int idx;
        {
            unsigned nx = 0; if (lane == 0) nx = __hip_atomic_fetch_add(ctr, 1u, __ATOMIC_RELAXED, __HIP_MEMORY_SCOPE_AGENT);
            nx = __builtin_amdgcn_readfirstlane(nx);
            idx = (int)nx;
            if (idx >= 576) break;
        }
        const int x = F.bid & 7;
        int type, b, hd, qt;
        if (idx < 128) { type = 1; b = idx >> 5; hd = x; qt = idx & 31; }
        else if (idx < 256) { const int mm = idx - 128; type = 2; b = x >> 1; hd = (x & 1) * 4 + (mm >> 5); qt = mm & 31; }
        else if (idx < 320) { const int mm = idx - 256, g = x + 8 * (mm >> 3); type = 3; b = g >> 2; hd = g & 3; qt = mm & 7; }
        else if (idx < 448) { const int mm = idx - 320; type = 4; b = mm >> 3; hd = x; qt = mm & 7; }
        else { const int mm = idx - 448, g = x + 8 * (mm >> 5); type = 5; b = g >> 1; hd = (g & 1) * 4 + ((mm >> 3) & 3); qt = mm & 7; }
        const bool lat = type < 3;
        const int seq0 = lat ? NCTX + b * 1024 : b * 256, T = lat ? 1024 : 256, q0 = 32 * qt;
        const int tile0 = seq0 >> 5, qtile = tile0 + qt, lo = lane * 8;
        const bf16* ckf = CKF + (size_t)b * 18 * 8 * 2048; const bf16* cvf = CVF + (size_t)b * 36 * 8 * 1024;
#define QK_TILE(c, t) (QKF + ((size_t)(c) * 256 + (t)) * 2048)
#define V_TILE(vdb, t) (VF + ((size_t)(vdb) * 256 + (t)) * 1024)
        if (type == 0 || type == 3) {
            f32x16 o[4]; float m, lsum;
#pragma unroll 1
            for (int i = paired ? ip : 0; i < (paired ? ip + 1 : 2); ++i) {
                bf16x8 qf[4];
#pragma unroll
                for (int ks = 0; ks < 4; ++ks) qf[ks] = *(const bf16x8*)(QK_TILE(36 + 2 * hd + i, qtile) + ks * 512 + lo);
#pragma unroll
                for (int db = 0; db < 4; ++db) o[db] = (f32x16){0.f, 0.f, 0.f, 0.f, 0.f, 0.f, 0.f, 0.f, 0.f, 0.f, 0.f, 0.f, 0.f, 0.f, 0.f, 0.f};
                m = -1e30f; lsum = 0.f;
                attn_seg<4, 0>(o, m, lsum, qf, QK_TILE(44 + 2 * hd + i, tile0), V_TILE(20 + 4 * hd, tile0), 256 * 1024, lo, T / 32, 0, 0, (const LAS float*)nullptr, h);
                if (lat) attn_seg<4, 0>(o, m, lsum, qf, ckf + (size_t)(10 + 2 * hd + i) * 8 * 2048, cvf + (size_t)(20 + 4 * hd) * 8 * 1024, 8 * 1024, lo, 8, 0, 0, (const LAS float*)nullptr, h);
                lsum += __shfl_xor(lsum, 32);
                const float il = 1.0f / lsum;
                if (i == 0) {
#pragma unroll
                    for (int db = 0; db < 4; ++db)
#pragma unroll
                        for (int r = 0; r < 16; ++r) park[(db * 16 + r) * 64] = o[db][r] * il;
                    if (paired) { asm volatile("s_waitcnt lgkmcnt(0)" ::: "memory"); if (lane == 0) *flagA = tag;
                        while (*flagB != tag) __builtin_amdgcn_s_sleep(8); }
                } else {
                    const LAS float* parkr = paired ? park - 4096 : park;
                    if (paired) { while (*flagA != tag) __builtin_amdgcn_s_sleep(8); asm volatile("" ::: "memory"); }
                    float ss = 0.f;
#pragma unroll
                    for (int db = 0; db < 4; ++db)
#pragma unroll
                        for (int r = 0; r < 16; ++r) { const float x = parkr[(db * 16 + r) * 64] - lam * (o[db][r] * il); o[db][r] = x; ss += x * x; }
                    if (paired) { asm volatile("s_waitcnt lgkmcnt(0)" ::: "memory"); if (lane == 0) *flagB = tag; }
                    ss += __shfl_xor(ss, 32);
                    const float rs = rsqrtf(ss * (1.0f / 128.0f) + 1e-6f) * (1.0f - lam_init);
                    const float* sub = A->in[21] + l * 128;
                    bf16* orow = MIX + (size_t)(seq0 + q0 + j) * DM + 1024 + 128 * hd;
#pragma unroll
                    for (int db = 0; db < 4; ++db)
#pragma unroll
                        for (int g = 0; g < 4; ++g) { const int d = 32 * db + 8 * g + 4 * h; const f32x4 sv = *(const f32x4*)(sub + d);
                            *(unsigned long long*)(orow + d) = (unsigned long long)cvtpk(o[db][4 * g] * rs * sv.x, o[db][4 * g + 1] * rs * sv.y) | ((unsigned long long)cvtpk(o[db][4 * g + 2] * rs * sv.z, o[db][4 * g + 3] * rs * sv.w) << 32); }
                }
            }
        } else {
            const bool na = (type == 1 || type == 4);
            const int cq = na ? 12 + hd : hd, ck = na ? 20 + hd : 8 + (hd >> 2), vdb = na ? 4 + 2 * hd : 2 * (hd >> 2);
            const int cck = na ? 2 + hd : (hd >> 2);
            bf16x8 qf[4];
#pragma unroll
            for (int ks = 0; ks < 4; ++ks) qf[ks] = *(const bf16x8*)(QK_TILE(cq, qtile) + ks * 512 + lo);
            f32x16 o[2];
#pragma unroll
            for (int db = 0; db < 2; ++db) o[db] = (f32x16){0.f, 0.f, 0.f, 0.f, 0.f, 0.f, 0.f, 0.f, 0.f, 0.f, 0.f, 0.f, 0.f, 0.f, 0.f, 0.f};
            float m = -1e30f, lsum = 0.f;
            if (!lat) attn_seg<2, 0>(o, m, lsum, qf, QK_TILE(ck, tile0), V_TILE(vdb, tile0), 256 * 1024, lo, 8, 0, 0, (const LAS float*)nullptr, h);
            else {
                attn_seg<2, 0>(o, m, lsum, qf, ckf + (size_t)cck * 8 * 2048, cvf + (size_t)vdb * 8 * 1024, 8 * 1024, lo, 8, 0, 0, (const LAS float*)nullptr, h);
                if (!na) { const int k0 = q0 - 128 < 0 ? 0 : q0 - 128, k1 = q0 + 160 > 1024 ? 1024 : q0 + 160;
                    attn_seg<2, 1>(o, m, lsum, qf, QK_TILE(ck, tile0 + (k0 >> 5)), V_TILE(vdb, tile0 + (k0 >> 5)), 256 * 1024, lo, (k1 - k0) / 32, q0 + j, k0, (const LAS float*)nullptr, h); }
                else { const int r = qt >> 1, c0 = 32 * (qt & 1); int kr0 = r - 4; kr0 = kr0 < 0 ? 0 : (kr0 > 8 ? 8 : kr0);
                    LAS float* tbl = (LAS float*)(F.lds + F.wave * 16384);
                    const float* rg = A->in[19] + (size_t)(l * 8 + hd) * 465;
#pragma unroll
                    for (int i = 0; i < 8; ++i) { const int e = lane + 64 * i; if (e < 465) tbl[(e / 31) * 127 + 48 + (e % 31)] = rg[e] * LOG2E; }
                    asm volatile("s_waitcnt lgkmcnt(0)" ::: "memory");
                    attn_seg<2, 2>(o, m, lsum, qf, QK_TILE(ck, tile0 + 2 * kr0), V_TILE(vdb, tile0 + 2 * kr0), 256 * 1024, lo, 16, c0 + j, kr0 - r + 7, tbl, h); }
            }
            lsum += __shfl_xor(lsum, 32);
            if (!na) { const float sk = A->in[18][l * 8 + hd] * LOG2E; const float mn = fmaxf(m, sk), alpha = __builtin_amdgcn_exp2f(m - mn); lsum = lsum * alpha + __builtin_amdgcn_exp2f(sk - mn);
#pragma unroll
                for (int db = 0; db < 2; ++db) o[db] = o[db] * alpha; }
            const float il = 1.0f / lsum;
            bf16* orow = MIX + (size_t)(seq0 + q0 + j) * DM + (na ? 512 : 0) + hd * 64;
#pragma unroll
            for (int db = 0; db < 2; ++db)
#pragma unroll
                for (int g = 0; g < 4; ++g) { const int d = 32 * db + 8 * g + 4 * h;
                    *(unsigned long long*)(orow + d) = (unsigned long long)cvtpk(o[db][4 * g] * il, o[db][4 * g + 1] * il) | ((unsigned long long)cvtpk(o[db][4 * g + 2] * il, o[db][4 * g + 3] * il) << 32); }
        }
    }
}
__device__ __forceinline__ float gelu_tanh(float x) { const float u = 0.7978845608028654f * (x + 0.044715f * x * x * x); const float e = __builtin_amdgcn_exp2f(-2.0f * LOG2E * u); return x * __builtin_amdgcn_rcpf(1.0f + e); }
__device__ __forceinline__ float sigm(float x) { return __builtin_amdgcn_rcpf(1.0f + __builtin_amdgcn_exp2f(-LOG2E * x)); }
constexpr int LRU_UB = 0, LRU_XS = 18432;
__device__ __forceinline__ void phase_lru_gates(const Frame& F, KArgs A, int l) {
    const bf16* PB = (const bf16*)(A->ws + WS_PB); const bf16* LW = (const bf16*)(A->ws + WS_LW); float* AB = (float*)(A->ws + WS_AB);
    LAS unsigned short* UB = (LAS unsigned short*)(F.lds + LRU_UB); LAS unsigned short* XS = (LAS unsigned short*)(F.lds + LRU_XS);
    const int tid = F.tid, lane = F.lane, j = lane & 31, h = lane >> 5, mt = F.wave & 3, nt = F.wave >> 2;
    const int dcol = nt * 32 + j, sseg = tid >> 6, sch = tid & 63;
#pragma unroll 1
    for (int u = F.bid; u < 512; u += F.G) {
        const int blk = u & 7, row0 = (u >> 3) * 128;
        const bool lat = row0 >= NCTX; const int T = lat ? 1024 : 256, t0 = lat ? (row0 & 1023) : (row0 & 255), r0 = row0 - t0;
        const float* cw = A->in[22] + l * 2048 + blk * 64; const float cbv = A->in[23][l * 512 + blk * 64 + sch];
        const float w0 = cw[sch], w1 = cw[512 + sch], w2 = cw[1024 + sch], w3 = cw[1536 + sch];
        const bf16* lxb = PB + (size_t)r0 * PROJW + C_LX + blk * 64 + sch;
        unsigned xv[17];
#pragma unroll
        for (int k = 0; k < 17; ++k) { int rr = sseg + 8 * k; rr = rr > 130 ? 130 : rr; const int t = t0 - 2 + rr; const int tc = t < 0 ? 0 : (t > T - 1 ? T - 1 : t); xv[k] = lxb[(size_t)tc * PROJW]; }
#pragma unroll
        for (int k = 0; k < 17; ++k) { int rr = sseg + 8 * k; rr = rr > 130 ? 130 : rr; const int t = t0 - 2 + rr; XS[rr * 64 + sch] = (unsigned short)((t >= 0 && t < T) ? xv[k] : 0u); }
        __syncthreads();
#pragma unroll
        for (int k = 0; k < 16; ++k) { const int tt = sseg + 8 * k;
            const float uu = cbv + w0 * bf2f(XS[tt * 64 + sch]) + w1 * bf2f(XS[(tt + 1) * 64 + sch]) + w2 * bf2f(XS[(tt + 2) * 64 + sch]) + w3 * bf2f(XS[(tt + 3) * 64 + sch]);
            UB[tt * 72 + sch] = (unsigned short)f2bf(uu); }
        __syncthreads();
        bf16x8 au[4];
#pragma unroll
        for (int ks = 0; ks < 4; ++ks) au[ks] = *(const LAS bf16x8*)(UB + (mt * 32 + j) * 72 + 16 * ks + 8 * h);
        const int chg = blk * 64 + dcol;
#pragma unroll 1
        for (int dir = 0; dir < 2; ++dir) {
            bf16x8 bw[2][4];
#pragma unroll
            for (int mat = 0; mat < 2; ++mat)
#pragma unroll
                for (int ks = 0; ks < 4; ++ks) bw[mat][ks] = *(const bf16x8*)(LW + ((size_t)((((l * 2 + dir) * 2 + mat) * 8 + blk) * 64 + dcol)) * 64 + 16 * ks + 8 * h);
            const float bav = A->in[25][(l * 2 + dir) * 512 + chg], bxv = A->in[27][(l * 2 + dir) * 512 + chg];
            const float Lv = A->in[28][(l * 2 + dir) * 512 + chg]; const float negk = -8.0f * LOG2E * log1pf(__expf(-Lv));
            f32x16 ga = {0.f, 0.f, 0.f, 0.f, 0.f, 0.f, 0.f, 0.f, 0.f, 0.f, 0.f, 0.f, 0.f, 0.f, 0.f, 0.f}, gx = ga;
#pragma unroll
            for (int ks = 0; ks < 4; ++ks) { ga = __builtin_amdgcn_mfma_f32_32x32x16_bf16(au[ks], bw[0][ks], ga, 0, 0, 0); gx = __builtin_amdgcn_mfma_f32_32x32x16_bf16(au[ks], bw[1][ks], gx, 0, 0, 0); }
            f32x16 ta = (ga + bav) * -LOG2E, tx = (gx + bxv) * -LOG2E;
#pragma unroll
            for (int r = 0; r < 16; ++r) { ta[r] = __builtin_amdgcn_exp2f(ta[r]); tx[r] = __builtin_amdgcn_exp2f(tx[r]); }
            ta = ta + 1.0f; tx = tx + 1.0f;
#pragma unroll
            for (int r = 0; r < 16; ++r) { ta[r] = __builtin_amdgcn_rcpf(ta[r]); tx[r] = __builtin_amdgcn_rcpf(tx[r]); }
            f32x16 av = ta * negk;
#pragma unroll
            for (int r = 0; r < 16; ++r) av[r] = __builtin_amdgcn_exp2f(av[r]);
            f32x16 om = 1.0f - av * av, uu;
#pragma unroll
            for (int r = 0; r < 16; ++r) { om[r] = __builtin_amdgcn_sqrtf(fmaxf(om[r], 0.f)); uu[r] = bf2f(UB[(mt * 32 + crow(r, h)) * 72 + dcol]); }
            const f32x16 bbv = om * (tx * uu);
            char* apu = (char*)(AB + ((size_t)dir * NTOK + row0 + mt * 32) * 512);
            const unsigned lofs = (unsigned)(chg + 4 * h * 512) * 4u;
#pragma unroll
            for (int r = 0; r < 16; ++r) { const int cr = (r & 3) + 8 * (r >> 2);
                *(float*)(apu + (size_t)cr * 2048 + lofs) = av[r]; *(float*)(apu + (size_t)2 * NTOK * 512 * 4 + (size_t)cr * 2048 + lofs) = bbv[r]; }
        }
        __syncthreads();
    }
}
constexpr int SC_SEGA = 0, SC_SEGH = 2048, SC_CAR = 4096;
__device__ __forceinline__ void phase_lru_scan(const Frame& F, KArgs A, int l) {
    if (F.bid >= 160) return;
    const bool lat = F.bid < 32; const int ub = lat ? F.bid : F.bid - 32; const int b = ub >> 3, blk = ub & 7;
    const int r0 = lat ? NCTX + b * 1024 : b * 256, T = lat ? 1024 : 256, nc = T / 128;
    const bf16* PB = (const bf16*)(A->ws + WS_PB); const float* AB = (const float*)(A->ws + WS_AB); float* HS = (float*)(A->ws + WS_HS); bf16* MIX = (bf16*)(A->ws + WS_MIX);
    const int tid = F.tid, seg = tid >> 6, sch = tid & 63, chg = blk * 64 + sch;
    LAS float* SEGA = (LAS float*)(F.lds + SC_SEGA); LAS float* SEGH = (LAS float*)(F.lds + SC_SEGH); LAS float* CAR = (LAS float*)(F.lds + SC_CAR);
    float* hs = HS + (size_t)r0 * 512 + chg;
#pragma unroll 1
    for (int dir = 0; dir < 2; ++dir) {
        const float* ap = AB + ((size_t)dir * NTOK + r0) * 512 + chg; const float* bp = ap + (size_t)2 * NTOK * 512;
        float hcarry = 0.f; if (lat && tid < 64) hcarry = A->in[8][((size_t)((b * 2 + l) * 2 + dir)) * 512 + chg];
        float av[16], bv[16];
        { const int ci = dir ? nc - 1 : 0;
#pragma unroll
          for (int k = 0; k < 16; ++k) { const int so = seg * 16 + k, tt = ci * 128 + (dir ? 127 - so : so); av[k] = ap[(size_t)tt * 512]; bv[k] = bp[(size_t)tt * 512]; } }
#pragma unroll 1
        for (int cc = 0; cc < nc; ++cc) {
            const int ci = dir ? nc - 1 - cc : cc;
            float hloc[16], pk[16]; float hl = 0.f, pp = 1.f;
#pragma unroll
            for (int k = 0; k < 16; ++k) { hl = av[k] * hl + bv[k]; pp *= av[k]; hloc[k] = hl; pk[k] = pp; }
            SEGA[seg * 64 + sch] = pp; SEGH[seg * 64 + sch] = hl;
            { const int cn = cc + 1 < nc ? cc + 1 : cc, cin_ = dir ? nc - 1 - cn : cn;
#pragma unroll
              for (int k = 0; k < 16; ++k) { const int so = seg * 16 + k, tt = cin_ * 128 + (dir ? 127 - so : so); av[k] = ap[(size_t)tt * 512]; bv[k] = bp[(size_t)tt * 512]; } }
            float hf[16]; unsigned lgv[16];
            if (dir) {
#pragma unroll
                for (int k = 0; k < 16; ++k) { const int so = seg * 16 + k, tt = ci * 128 + 127 - so; hf[k] = hs[(size_t)tt * 512]; lgv[k] = PB[(size_t)(r0 + tt) * PROJW + C_LG + chg]; }
            }
            __syncthreads();
            if (tid < 64) { float c = hcarry;
#pragma unroll
                for (int s2 = 0; s2 < 8; ++s2) { CAR[s2 * 64 + sch] = c; c = SEGA[s2 * 64 + sch] * c + SEGH[s2 * 64 + sch]; }
                hcarry = c; }
            __syncthreads();
            const float cin = CAR[seg * 64 + sch];
            if (!dir) {
#pragma unroll
                for (int k = 0; k < 16; ++k) { const int so = seg * 16 + k; hs[(size_t)(ci * 128 + so) * 512] = hloc[k] + pk[k] * cin; }
            } else {
#pragma unroll
                for (int k = 0; k < 16; ++k) { const int so = seg * 16 + k, tt = ci * 128 + 127 - so;
                    MIX[(size_t)(r0 + tt) * DM + 1536 + chg] = (bf16)f2bf((hf[k] + hloc[k] + pk[k] * cin) * gelu_tanh(bf2f((unsigned short)lgv[k]))); }
            }
        }
        if (!lat && tid < 64) A->out[O_LRU + ((size_t)((b * 2 + l) * 2 + dir)) * 512 + chg] = hcarry;
        asm volatile("s_waitcnt vmcnt(0)" ::: "memory");
        __syncthreads();
    }
}
struct EpiProj {
    static constexpr bool PERM = false, AFTER_DRAIN = false;
    bf16* PBp; bf16* QKFp; bf16* VTp; float* outp; const float* gain; const float* ropeT; int l;
    __device__ __forceinline__ void operator()(const pg8::f32x4 (&acc)[2][2][4][2], const pg8::Unit& u, int wr, int wc, int fr, int fq) const {
        asm volatile("" : "+v"(fr), "+v"(fq));
        const int c = 4 * u.pn + wc;
        int gi = -1; bool rope = false; size_t oofs = 0; int ow = 0, oc = 0, vcol0 = -1; bool hasout = false;
        if (c < 8) { gi = 0; rope = true; }
        else if (c < 10) { gi = 1; rope = true; hasout = true; oofs = O_SWAK; ow = 128; oc = c - 8; }
        else if (c < 12) { hasout = true; oofs = O_SWAV; ow = 128; oc = c - 10; vcol0 = (c - 10) * 64; }
        else if (c < 20) { gi = 2; }
        else if (c < 28) { gi = 3; hasout = true; oofs = O_NAK; ow = 512; oc = c - 20; }
        else if (c < 36) { hasout = true; oofs = O_NAV; ow = 512; oc = c - 28; vcol0 = 128 + (c - 28) * 64; }
        else if (c < 44) { gi = 4; rope = true; }
        else if (c < 52) { gi = 5; rope = true; hasout = true; oofs = O_DFK; ow = 512; oc = c - 44; }
        else if (c < 60) { hasout = true; oofs = O_DFV; ow = 512; oc = c - 52; vcol0 = 640 + (c - 52) * 64; }
        const bool lat = u.pm >= 16;
        const int dbase = 32 * (fq >> 1) + 8 * (fq & 1);
        pg8::f32x4 gv[2][2];
        if (gi >= 0) {
#pragma unroll
            for (int bj = 0; bj < 2; ++bj)
#pragma unroll
                for (int n = 0; n < 2; ++n) { gv[bj][n] = *(const pg8::f32x4*)(gain + gi * 64 + dbase + 16 * bj + 4 * n);
                    if ((gi & 1) == 0) gv[bj][n] = gv[bj][n] * SM_SCALE; }
        }
#pragma unroll
        for (int ai = 0; ai < 2; ++ai)
#pragma unroll
            for (int m = 0; m < 4; ++m) {
                const int row = u.pm * 256 + ai * 128 + wr * 64 + m * 16 + fr;
                pg8::f32x4 x[2][2];
#pragma unroll
                for (int bj = 0; bj < 2; ++bj)
#pragma unroll
                    for (int n = 0; n < 2; ++n) x[bj][n] = acc[ai][bj][m][n];
                if (gi >= 0) {
                    float ss = 0.f;
#pragma unroll
                    for (int bj = 0; bj < 2; ++bj)
#pragma unroll
                        for (int n = 0; n < 2; ++n) ss += (x[bj][n][0] * x[bj][n][0] + x[bj][n][1] * x[bj][n][1]) + (x[bj][n][2] * x[bj][n][2] + x[bj][n][3] * x[bj][n][3]);
                    ss += __shfl_xor(ss, 16); ss += __shfl_xor(ss, 32);
                    const float rs = rsqrtf(ss * (1.0f / 64.0f) + 1e-6f);
#pragma unroll
                    for (int bj = 0; bj < 2; ++bj)
#pragma unroll
                        for (int n = 0; n < 2; ++n) x[bj][n] = x[bj][n] * rs * gv[bj][n];
                    if (rope && lat) {
                        const int t = row & 1023; const int pos = (fq >> 1) ? (t & 63) : (t >> 6);
#pragma unroll
                        for (int n = 0; n < 2; ++n) { const pg8::f32x4 cs = *(const pg8::f32x4*)(ropeT + pos * 16 + 8 * (fq & 1) + 4 * n), sn = *(const pg8::f32x4*)(ropeT + 1024 + pos * 16 + 8 * (fq & 1) + 4 * n);
                            const pg8::f32x4 x1 = x[0][n], x2 = x[1][n]; x[0][n] = x1 * cs - x2 * sn; x[1][n] = x2 * cs + x1 * sn; }
                    }
                }
                if (vcol0 < 0) {
                    bf16* pr = c >= 60 ? PBp + (size_t)row * PROJW + c * 64 + dbase
                                       : QKFp + ((size_t)c * 256 + (row >> 5)) * 2048 + (2 * (fq >> 1)) * 512 + (fq & 1) * 256 + (row & 31) * 8;
                    const int bjs = c >= 60 ? 16 : 512;
#pragma unroll
                    for (int bj = 0; bj < 2; ++bj) { pg8::u32x4 w; w.x = cvtpk(x[bj][0][0], x[bj][0][1]); w.y = cvtpk(x[bj][0][2], x[bj][0][3]); w.z = cvtpk(x[bj][1][0], x[bj][1][1]); w.w = cvtpk(x[bj][1][2], x[bj][1][3]);
                        *(pg8::u32x4*)(pr + bjs * bj) = w; }
                }
                if (hasout && !lat) { float* o = outp + oofs + ((size_t)((row >> 8) * 2 + l) * 256 + (row & 255)) * ow + oc * 64 + dbase;
#pragma unroll
                    for (int bj = 0; bj < 2; ++bj)
#pragma unroll
                        for (int n = 0; n < 2; ++n) *(pg8::f32x4*)(o + 16 * bj + 4 * n) = x[bj][n]; }
                if (vcol0 >= 0) {
                    const int p = vt_pos(row & 31);
                    bf16* vt = VTp + ((size_t)((vcol0 + dbase) >> 5) * 256 + (row >> 5)) * 1024 + (p >> 3) * 256 + ((dbase & 31)) * 8 + (p & 7);
#pragma unroll
                    for (int bj = 0; bj < 2; ++bj)
#pragma unroll
                        for (int n = 0; n < 2; ++n)
#pragma unroll
                            for (int i = 0; i < 4; ++i) vt[(16 * bj + 4 * n + i) * 8] = (bf16)(cvtpk(x[bj][n][i], 0.f) & 0xffffu);
                }
            }
    }
};
#ifndef PROBE_MASK
#define PROBE_MASK 0u
#endif
__device__ __forceinline__ Frame mkframe(LAS unsigned char* lds) {
    Frame F; int tid = threadIdx.x; asm volatile("" : "+v"(tid)); int bid = blockIdx.x; asm volatile("" : "+s"(bid));
    F.lds = lds; F.tid = tid; F.lane = tid & 63; F.wave = __builtin_amdgcn_readfirstlane(tid >> 6); F.G = gridDim.x; F.bid = bid;
    F.gtid = bid * 512 + tid; F.gthreads = F.G * 512; F.gwave = bid * NWAVES + F.wave; F.gwaves = F.G * NWAVES;
    return F;
}
__global__ void __launch_bounds__(NWAVES * 64, 2) fwd_kernel(Args args) {
    extern __shared__ __attribute__((aligned(16))) unsigned char lds[];
    LAS unsigned char* L = (LAS unsigned char*)lds;
    volatile LAS unsigned* MISC = (volatile LAS unsigned*)(L + MISC_OFF);
    for (int u = threadIdx.x; u < (LDS_BYTES - LDSCTL_OFF) / 4; u += NWAVES * 64) ((LAS unsigned*)(L + LDSCTL_OFF))[u] = 0u;
    __syncthreads();
    const bool multi = (args.ph_hi - args.ph_lo) > 1;
    XcdBarrier bar; bar.bar = (unsigned*)(args.ws + WS_CTL) + CW_BAR; bar.x = 0; bar.st = nullptr;
    if (multi) bar = xcd_barrier_post((unsigned*)(args.ws + WS_CTL) + CW_BAR, MISC + 8);
    PG8_LAS unsigned char* ring = (PG8_LAS unsigned char*)lds;
#pragma unroll 1
    for (int p = args.ph_lo; p < args.ph_hi; ++p) {
      if (p == 1) continue;
#pragma unroll 1
      for (int rep = 0; rep < (int)((args.probe >> (p == 0 ? 0 : (p == 1 ? 31 : 1 + (p - 2) % 8))) & 1u) + 1; ++rep) {
        if (rep) xcd_barrier(bar);
        const Frame F = mkframe(L);
        KArgs A = (KArgs)__builtin_amdgcn_kernarg_segment_ptr(); asm volatile("" : "+s"(A));
        if (p == 0) phase_prologue(F, A);
        else if (p == 1) { }
        else {
            const int l = (p - 2) / 8, q = (p - 2) % 8;
            const float* modv = (const float*)(A->ws + WS_MODV) + (size_t)l * 5 * MODW;
            if (q == 0) { if (l == 0) phase_modfinal(F, A); phase_modnorm(F, A, l, 0); }
            else if (q == 1) {
                pg8::Gemm g{(const pg8::bf16_t*)(A->ws + WS_H), (const pg8::bf16_t*)(A->ws + WS_WIN) + (size_t)l * PROJW * DM, NTOK, PROJW, DM};
                pg8::StaticOrder S; S.init(NTOK, PROJW, F.G, F.bid);
                EpiProj E{(bf16*)(A->ws + WS_PB), (bf16*)(A->ws + WS_QKF), (bf16*)(A->ws + WS_VT), A->out, A->in[17] + l * 384, (const float*)(A->ws + WS_ROPE), l};
                pg8::gemm_phase<EpiProj, pg8::StaticOrder, true, true>(ring, g, S, E);
            }
            else if (q == 2) phase_lru_gates(F, A, l);
            else if (q == 3) { phase_lru_scan(F, A, l); phase_attn(F, A, l, rep); }
            else if (q == 4) {
                pg8::Gemm g{(const pg8::bf16_t*)(A->ws + WS_MIX), (const pg8::bf16_t*)(A->ws + WS_WOUT) + (size_t)l * DM * DM, NTOK, DM, DM};
                pg8::StaticOrder S; S.init(NTOK, DM, F.G, F.bid);
                EpiResid E{l == 0 ? A->in[0] : A->out + O_Y, l == 0 ? A->in[1] : A->out + O_Y + (size_t)NCTX * DM, A->out + O_Y, modv + 2 * DM};
                pg8::gemm_phase<EpiResid, pg8::StaticOrder, true, true>(ring, g, S, E);
            }
            else if (q == 5) phase_modnorm(F, A, l, 1);
            else if (q == 6) {
                pg8::Gemm g{(const pg8::bf16_t*)(A->ws + WS_H), (const pg8::bf16_t*)(A->ws + WS_WGU) + (size_t)l * 2 * FFNH * DM, NTOK, 2 * FFNH, DM};
                pg8::StaticOrder S; S.init(NTOK, 2 * FFNH, F.G, F.bid);
                EpiSwiGLU E{(pg8::bf16_t*)(A->ws + WS_HM)};
                pg8::gemm_phase<EpiSwiGLU, pg8::StaticOrder, true, true>(ring, g, S, E);
            }
            else {
                pg8::Gemm g{(const pg8::bf16_t*)(A->ws + WS_HM), (const pg8::bf16_t*)(A->ws + WS_WDN) + (size_t)l * DM * FFNH, NTOK, DM, FFNH};
                pg8::StaticOrder S; S.init(NTOK, DM, F.G, F.bid);
                EpiResid E{A->out + O_Y, A->out + O_Y + (size_t)NCTX * DM, A->out + O_Y, modv + 5 * DM};
                pg8::gemm_phase<EpiResid, pg8::StaticOrder, true, true>(ring, g, S, E);
            }
        }
      }
        if (p + 1 < args.ph_hi) xcd_barrier(bar);
    }
}

constexpr int N_PHASES = 18;
#ifndef ONE_LAUNCH
#define ONE_LAUNCH 1
#endif
extern "C" void kernel_launch(void* const* d_in, const int* in_sizes, int n_in, void* d_out, int out_size, void* d_ws, size_t ws_size, hipStream_t stream) {
    static int grid = 0;
    if (grid == 0) {
        if (n_in != 32 || out_size != 35684352 || ws_size < WS_END) { fprintf(stderr, "kernel_launch: unexpected shapes n_in %d out %d ws %zu\n", n_in, out_size, ws_size); grid = -1; return; }
        int dev = 0, cus = 0, per_cu = 0;
        if (hipGetDevice(&dev) != hipSuccess || hipDeviceGetAttribute(&cus, hipDeviceAttributeMultiprocessorCount, dev) != hipSuccess) { grid = -1; return; }
        if (hipFuncSetAttribute((const void*)fwd_kernel, hipFuncAttributeMaxDynamicSharedMemorySize, LDS_BYTES) != hipSuccess) { fprintf(stderr, "kernel_launch: hipFuncSetAttribute failed\n"); grid = -1; return; }
        if (hipOccupancyMaxActiveBlocksPerMultiprocessor(&per_cu, (const void*)fwd_kernel, NWAVES * 64, LDS_BYTES) != hipSuccess || per_cu < 1) fprintf(stderr, "kernel_launch: occupancy query reports %d\n", per_cu);
        (void)hipGetLastError();
        grid = cus;
    }
    if (grid < 0) return;
    if (hipMemsetAsync((char*)d_ws + WS_CTL, 0, CTL_ZERO_BYTES, stream) != hipSuccess) return;
    Args a{};
    for (int i = 0; i < 32; ++i) a.in[i] = (const float*)d_in[i];
    a.out = (float*)d_out; a.ws = (unsigned char*)d_ws;
#if ONE_LAUNCH
    a.ph_lo = 0; a.ph_hi = N_PHASES; a.probe = PROBE_MASK;
    hipLaunchKernelGGL(fwd_kernel, dim3(grid), dim3(NWAVES * 64), LDS_BYTES, stream, a);
#else
    for (int p = 0; p < N_PHASES; ++p) { a.ph_lo = p; a.ph_hi = p + 1; hipLaunchKernelGGL(fwd_kernel, dim3(grid), dim3(NWAVES * 64), LDS_BYTES, stream, a); }
#endif
}
```

```cpp
#include <hip/hip_runtime.h>
#include <cstdio>
#include <cstdint>
#include <cstddef>
namespace pg8 {
#define PG8_LAS __attribute__((address_space(3)))
typedef unsigned short bf16_t;
typedef short bf16x8 __attribute__((ext_vector_type(8)));
typedef float f32x4 __attribute__((ext_vector_type(4)));
typedef unsigned u32x4 __attribute__((ext_vector_type(4)));
constexpr int BM = 256, BK = 64, HALF = 128, HTB = HALF * BK * 2  , STAGE_BYTES = 8 * HTB, NXCD = 8, WGM = 8;

__host__ __device__ __forceinline__ int lds_byte(int r, int c) { return (r >> 3) * 1024 + (r & 7) * 128 + (((c >> 3) ^ ((r >> 1) & 7)) * 16) + (c & 7) * 2; }
__host__ __device__ __forceinline__ void stage_rc(int b, int& R, int& C) { const int st = b >> 10, p = b & 1023; R = st * 8 + (p >> 7); C = ((((p >> 4) & 7) ^ ((R >> 1) & 7)) * 8) + ((p & 15) >> 1); }
__host__ __device__ __forceinline__ int perm32(int rho) { const int n = rho >> 4, i = rho & 15; return 8 * (i >> 2) + 4 * n + (i & 3); }

struct Unit { int pm, pn; };
struct Gemm { const bf16_t* A; const bf16_t* Bt; int M, N, K; };

struct StaticOrder {
    int nM, nN, nwg, G, c;
    __host__ __device__ void init(int M, int N, int G_, int c_) { nM = M / BM; nN = N / BM; nwg = nM * nN; G = G_; c = c_; }
    __host__ __device__ bool next(int i, Unit& u) const {
        const long L = (long)i * G + c; if (L >= nwg) return false;
        int wgid = (int)L; { const int q = nwg / NXCD, r = nwg % NXCD, xcd = wgid % NXCD, off = wgid / NXCD; wgid = (xcd < r ? xcd * (q + 1) : r * (q + 1) + (xcd - r) * q) + off; }
        const int nig = WGM * nN, gid = wgid / nig, fm = gid * WGM, gsz = (nM - fm) < WGM ? (nM - fm) : WGM;
        u.pm = fm + ((wgid % nig) % gsz); u.pn = (wgid % nig) / gsz; return true;
    }
    __device__ __forceinline__ void a_ready(const Unit&) const {}
    __device__ __forceinline__ void done(const Unit&) const {}
};

__device__ __forceinline__ unsigned cvt_pk_bf16(float lo, float hi) { unsigned r; asm volatile("v_cvt_pk_bf16_f32 %0, %1, %2" : "=v"(r) : "v"(lo), "v"(hi)); return r; }
template <class Epi, class Sched, bool ALIGN_EPI = false, bool SP2 = false>
__device__ __forceinline__ void gemm_phase(PG8_LAS unsigned char* lds, const Gemm g, const Sched& S, const Epi& E) {
    int tid_ = threadIdx.x; asm volatile("" : "+v"(tid_)); const int tid = tid_, wid = __builtin_amdgcn_readfirstlane(tid >> 6), lane = tid & 63, wr = wid >> 2, wc = wid & 3, fr = lane & 15, fq = lane >> 4;
    const int K = g.K, nt = K / BK;
    unsigned voffA[2], voffB[2];
#pragma unroll
    for (int i = 0; i < 2; ++i) { int R, C; stage_rc(tid * 16 + i * 8192, R, C); const int Rb = Epi::PERM ? ((R & ~31) + perm32(R & 31)) : R;
        voffA[i] = (unsigned)(R * K + C) * 2u; voffB[i] = (unsigned)(Rb * K + C) * 2u; }
    const size_t kstep = (size_t)(BK * 2);
    const size_t hstep = (size_t)HALF * K * 2;
    const size_t tstep = 2 * hstep;
    const unsigned ldsw = (unsigned)wid * 1024u;
    const int aoffk[2] = {lds_byte(wr * 64 + fr, fq * 8), lds_byte(wr * 64 + fr, 32 + fq * 8)}, boffk[2] = {lds_byte(wc * 32 + fr, fq * 8), lds_byte(wc * 32 + fr, 32 + fq * 8)};
#define PG8_SA(b, h) (((b) * 2 + (h)) * HTB)
#define PG8_SB(b, h) ((4 + (b) * 2 + (h)) * HTB)
#define PG8_STAGE(bufoff, gbase, voff) do { _Pragma("unroll") for (int _i = 0; _i < 2; ++_i) \
        __builtin_amdgcn_global_load_lds((const unsigned*)((const char*)(gbase) + (voff)[_i]), (PG8_LAS unsigned*)(lds + (bufoff) + ldsw + _i * 8192), 16, 0, 0); } while (0)
#define PG8_LDA(dst, b, h) do { _Pragma("unroll") for (int m = 0; m < 4; ++m) _Pragma("unroll") for (int k = 0; k < 2; ++k) dst[m][k] = *(const PG8_LAS bf16x8*)(lds + PG8_SA(b, h) + aoffk[k] + m * 2048); } while (0)
#define PG8_LDB(dst, b, h) do { _Pragma("unroll") for (int n = 0; n < 2; ++n) _Pragma("unroll") for (int k = 0; k < 2; ++k) dst[n][k] = *(const PG8_LAS bf16x8*)(lds + PG8_SB(b, h) + boffk[k] + n * 2048); } while (0)
#define PG8_MMA(ai, bj, At, Bt) do { __builtin_amdgcn_s_setprio(1); _Pragma("unroll") for (int m = 0; m < 4; ++m) _Pragma("unroll") for (int n = 0; n < 2; ++n) _Pragma("unroll") for (int k = 0; k < 2; ++k) \
        acc[ai][bj][m][n] = __builtin_amdgcn_mfma_f32_16x16x32_bf16(Bt[n][k], At[m][k], acc[ai][bj][m][n], 0, 0, 0); __builtin_amdgcn_s_setprio(0); } while (0)
#define PG8_WAIT_V(n) asm volatile("s_waitcnt vmcnt(" #n ")" ::: "memory")
#define PG8_WAIT_L(n) asm volatile("s_waitcnt lgkmcnt(" #n ")" ::: "memory")
#define PG8_BAR __builtin_amdgcn_s_barrier()
#define PG8_SCHED __builtin_amdgcn_sched_barrier(0)
    Unit cur, nxt; int ui = 0;
    if (!S.next(0, cur)) return;
    f32x4 acc[2][2][4][2];
#pragma unroll
    for (int a = 0; a < 2; ++a)
#pragma unroll
        for (int b = 0; b < 2; ++b)
#pragma unroll
            for (int m = 0; m < 4; ++m)
#pragma unroll
                for (int n = 0; n < 2; ++n) acc[a][b][m][n] = (f32x4){0.f, 0.f, 0.f, 0.f};
    bf16x8 At[4][2], B0[2][2], B1[2][2];
    const char* cA = (const char*)g.A + (size_t)cur.pm * tstep; const char* cB = (const char*)g.Bt + (size_t)cur.pn * tstep;
    S.a_ready(cur);
    if constexpr (SP2) {
        PG8_STAGE(PG8_SB(0, 0), cB, voffB); PG8_STAGE(PG8_SB(0, 1), cB + hstep, voffB); PG8_STAGE(PG8_SA(0, 0), cA, voffA); PG8_STAGE(PG8_SA(0, 1), cA + hstep, voffA);
        if (wr == 1) PG8_BAR;
        PG8_WAIT_V(2); PG8_BAR;
        PG8_STAGE(PG8_SB(1, 0), cB + kstep, voffB); PG8_STAGE(PG8_SA(1, 0), cA + kstep, voffA); PG8_STAGE(PG8_SB(1, 1), cB + hstep + kstep, voffB);
        PG8_WAIT_V(6); PG8_BAR;
    } else {
        PG8_STAGE(PG8_SB(0, 0), cB, voffB); PG8_STAGE(PG8_SA(0, 0), cA, voffA); PG8_STAGE(PG8_SB(0, 1), cB + hstep, voffB); PG8_STAGE(PG8_SA(0, 1), cA + hstep, voffA);
        if (wr == 1) PG8_BAR;
        PG8_WAIT_V(4); PG8_BAR;
        PG8_STAGE(PG8_SB(1, 0), cB + kstep, voffB); PG8_STAGE(PG8_SA(1, 0), cA + kstep, voffA); PG8_STAGE(PG8_SB(1, 1), cB + hstep + kstep, voffB);
        PG8_WAIT_V(6); PG8_BAR;
    }
    for (;;) {
        const bool has_next = S.next(ui + 1, nxt);
        const char* nA = has_next ? (const char*)g.A + (size_t)nxt.pm * tstep : cA; const char* nB = has_next ? (const char*)g.Bt + (size_t)nxt.pn * tstep : cB;
        for (int t = 0; t < nt; t += 2) {
            const bool last = (t == nt - 2);
            const char* a1 = cA + (size_t)(t + 1) * kstep;
            const char* a2 = last ? nA : cA + (size_t)(t + 2) * kstep; const char* b2 = last ? nB : cB + (size_t)(t + 2) * kstep;
            const char* a3 = a2 + kstep; const char* b3 = b2 + kstep;
            if (last && has_next) S.a_ready(nxt);
            if constexpr (SP2) {
            PG8_LDB(B0, 0, 0); PG8_LDB(B1, 0, 1); PG8_SCHED; PG8_LDA(At, 0, 0); PG8_STAGE(PG8_SA(1, 1), a1 + hstep, voffA);
            PG8_WAIT_V(8); PG8_WAIT_L(0); PG8_BAR; PG8_MMA(0, 0, At, B0); PG8_MMA(0, 1, At, B1); PG8_BAR; PG8_SCHED;
            PG8_LDA(At, 0, 1); PG8_STAGE(PG8_SB(0, 0), b2, voffB); PG8_STAGE(PG8_SB(0, 1), b2 + hstep, voffB); PG8_STAGE(PG8_SA(0, 0), a2, voffA);
            PG8_WAIT_V(8); PG8_WAIT_L(0); PG8_BAR; PG8_MMA(1, 0, At, B0); PG8_MMA(1, 1, At, B1); PG8_BAR; PG8_SCHED;
            PG8_LDB(B0, 1, 0); PG8_LDB(B1, 1, 1); PG8_SCHED; PG8_LDA(At, 1, 0); PG8_STAGE(PG8_SA(0, 1), a2 + hstep, voffA);
            PG8_WAIT_V(8); PG8_WAIT_L(0); PG8_BAR; PG8_MMA(0, 0, At, B0); PG8_MMA(0, 1, At, B1); PG8_BAR; PG8_SCHED;
            PG8_LDA(At, 1, 1); PG8_STAGE(PG8_SB(1, 0), b3, voffB); PG8_STAGE(PG8_SB(1, 1), b3 + hstep, voffB); PG8_STAGE(PG8_SA(1, 0), a3, voffA);
            PG8_WAIT_V(8); PG8_WAIT_L(0); PG8_BAR; PG8_MMA(1, 0, At, B0); PG8_MMA(1, 1, At, B1); PG8_BAR; PG8_SCHED;
            } else {
            PG8_LDB(B0, 0, 0); PG8_SCHED; PG8_LDA(At, 0, 0); PG8_STAGE(PG8_SA(1, 1), a1 + hstep, voffA);
            PG8_WAIT_L(8); PG8_BAR; PG8_WAIT_L(0); PG8_MMA(0, 0, At, B0); PG8_BAR; PG8_SCHED;
            PG8_LDB(B1, 0, 1); PG8_STAGE(PG8_SB(0, 0), b2, voffB);
            PG8_BAR; PG8_WAIT_L(0); PG8_MMA(0, 1, At, B1); PG8_BAR;
            PG8_LDA(At, 0, 1); PG8_STAGE(PG8_SA(0, 0), a2, voffA);
            PG8_BAR; PG8_WAIT_L(0); PG8_MMA(1, 0, At, B0); PG8_BAR; PG8_SCHED;
            PG8_STAGE(PG8_SB(0, 1), b2 + hstep, voffB);
            PG8_WAIT_V(6); PG8_BAR; PG8_MMA(1, 1, At, B1); PG8_BAR;
            PG8_LDB(B0, 1, 0); PG8_SCHED; PG8_LDA(At, 1, 0); PG8_STAGE(PG8_SA(0, 1), a2 + hstep, voffA);
            PG8_WAIT_L(8); PG8_BAR; PG8_WAIT_L(0); PG8_MMA(0, 0, At, B0); PG8_BAR; PG8_SCHED;
            PG8_LDB(B1, 1, 1); PG8_STAGE(PG8_SB(1, 0), b3, voffB);
            PG8_BAR; PG8_WAIT_L(0); PG8_MMA(0, 1, At, B1); PG8_BAR;
            PG8_LDA(At, 1, 1); PG8_STAGE(PG8_SA(1, 0), a3, voffA);
            PG8_BAR; PG8_WAIT_L(0); PG8_MMA(1, 0, At, B0); PG8_BAR; PG8_SCHED;
            PG8_STAGE(PG8_SB(1, 1), b3 + hstep, voffB);
            PG8_WAIT_V(6); PG8_BAR; PG8_MMA(1, 1, At, B1); PG8_BAR;
            }
        }
        if constexpr (ALIGN_EPI) { if (wr == 0) PG8_BAR; }
        if constexpr (!Epi::AFTER_DRAIN) { E(acc, cur, wr, wc, fr, fq); S.done(cur); }
        if (!has_next) break;
#pragma unroll
        for (int a = 0; a < 2; ++a)
#pragma unroll
            for (int b = 0; b < 2; ++b)
#pragma unroll
                for (int m = 0; m < 4; ++m)
#pragma unroll
                    for (int n = 0; n < 2; ++n) acc[a][b][m][n] = (f32x4){0.f, 0.f, 0.f, 0.f};
        cur = nxt; cA = nA; cB = nB; ++ui;
        if constexpr (ALIGN_EPI) { if (wr == 1) PG8_BAR; }
    }
    PG8_WAIT_V(0);
    if constexpr (!ALIGN_EPI) { if (wr == 0) PG8_BAR; }
    PG8_BAR;
    if constexpr (Epi::AFTER_DRAIN) { E.fused(acc, cur, wr, wc, fr, fq, lds, wid, lane); S.done(cur); }
#undef PG8_SA
#undef PG8_SB
#undef PG8_STAGE
#undef PG8_LDA
#undef PG8_LDB
#undef PG8_MMA
#undef PG8_WAIT_V
#undef PG8_WAIT_L
#undef PG8_BAR
#undef PG8_SCHED
}
}
#define GAS __attribute__((address_space(1)))
#define LAS __attribute__((address_space(3)))
typedef unsigned short bf16;
typedef unsigned v4u __attribute__((ext_vector_type(4)));
typedef float f32x4 __attribute__((ext_vector_type(4)));
typedef short bf16x8 __attribute__((ext_vector_type(8)));
typedef GAS unsigned gu32;
typedef GAS unsigned long long gu64;
#define RLX_AGENT __ATOMIC_RELAXED, __HIP_MEMORY_SCOPE_AGENT
#define LDS_WAIT() asm volatile("s_waitcnt lgkmcnt(0)" ::: "memory")
#define VM_WAIT() asm volatile("s_waitcnt vmcnt(0)" ::: "memory")
__device__ __forceinline__ unsigned long long rt() { return __builtin_amdgcn_s_memrealtime(); }
__device__ __forceinline__ unsigned pk2(float lo, float hi) { unsigned r; asm("v_cvt_pk_bf16_f32 %0, %1, %2" : "=v"(r) : "v"(lo), "v"(hi)); return r; }
__device__ __forceinline__ unsigned f2bf(float f) { return pk2(f, 0.f) & 0xffffu; }

#define XB_TMO      128
#define XB_XCNT(j)  (256  + 64 * (j))
#define XB_XSUB(j)  (1280 + 64 * (j))
#define XB_XGEN(j)  (2304 + 64 * (j))
#define XB_TOP      3328
#define XB_TOPGEN   3392
#define XCD_BAR_WORDS 3456
#define XB_SPIN_CAP (1u << 18)

__device__ __forceinline__ unsigned xb_ld(unsigned* p)              { return __hip_atomic_load(p, __ATOMIC_RELAXED, __HIP_MEMORY_SCOPE_AGENT); }
__device__ __forceinline__ unsigned xb_add(unsigned* p, unsigned v) { return __hip_atomic_fetch_add(p, v, __ATOMIC_RELAXED, __HIP_MEMORY_SCOPE_AGENT); }
__device__ __forceinline__ unsigned xb_xcc_id() { return (unsigned)__builtin_amdgcn_s_getreg((3 << 11) | 20) & 0xFu; }
#define XB_SPIN(cond, bar) do { unsigned _sp = 0; while (cond) { __builtin_amdgcn_s_sleep(1); \
    if ((++_sp & 255u) == 0u) { if (xb_ld(&(bar)[XB_TMO])) break; if (_sp > XB_SPIN_CAP) { atomicAdd(&(bar)[XB_TMO], 1u); break; } } } } while (0)

struct XcdBarrier {
    unsigned* bar; unsigned x;
    volatile LAS unsigned* st;
};

__device__ __forceinline__ XcdBarrier xcd_barrier_post(unsigned* bar, volatile LAS unsigned* st) {
    XcdBarrier b; b.bar = bar; b.x = xb_xcc_id(); b.st = st;
    if (threadIdx.x == 0) (void)xb_add(&bar[XB_XCNT(b.x)], 1u);
    return b;
}
__device__ __forceinline__ void xcd_barrier_complete(unsigned* bar, unsigned x, unsigned& nloc, unsigned& nx) {
    const unsigned G = gridDim.x * gridDim.y * gridDim.z;
    unsigned sum, cnt, mine, sp = 0u;
    for (;;) {
        sum = 0u; cnt = 0u; mine = 0u;
#pragma unroll
        for (unsigned j = 0; j < 16; ++j) { const unsigned c = xb_ld(&bar[XB_XCNT(j)]); sum += c; cnt += (c > 0u) ? 1u : 0u; mine = (j == x) ? c : mine; }
        if (sum == G) break;
        __builtin_amdgcn_s_sleep(1);
        if ((++sp & 255u) == 0u) { if (xb_ld(&bar[XB_TMO])) break; if (sp > XB_SPIN_CAP) { atomicAdd(&bar[XB_TMO], 1u); break; } }
    }
    nloc = mine > 0u ? mine : 1u; nx = cnt > 0u ? cnt : 1u;
}

__device__ __forceinline__ void xcd_barrier(const XcdBarrier& b) {
    asm volatile("s_waitcnt vmcnt(0)" ::: "memory");
    __syncthreads();
    if (threadIdx.x == 0) {
        unsigned* bar = b.bar;
        __builtin_amdgcn_s_waitcnt(0);
        unsigned nloc = b.st[0], nx = b.st[1];
        if (nloc == 0u) { xcd_barrier_complete(bar, b.x, nloc, nx); b.st[0] = nloc; b.st[1] = nx; }
        const unsigned old = xb_add(&bar[XB_XSUB(b.x)], 1u);
        const unsigned gen = old / nloc;
        if (old + 1u == (gen + 1u) * nloc) {
            __builtin_amdgcn_fence(__ATOMIC_RELEASE, "agent");
            asm volatile("s_waitcnt vmcnt(0)" ::: "memory");
            const unsigned og = xb_add(&bar[XB_TOP], 1u);
            const unsigned tg = og / nx;
            if (og + 1u == (tg + 1u) * nx) xb_add(&bar[XB_TOPGEN], 1u);
            else XB_SPIN(xb_ld(&bar[XB_TOPGEN]) == tg, bar);
            __builtin_amdgcn_fence(__ATOMIC_ACQUIRE, "agent");
            xb_add(&bar[XB_XGEN(b.x)], 1u);
            asm volatile("s_waitcnt vmcnt(0)" ::: "memory");
        } else {
            XB_SPIN(xb_ld(&bar[XB_XGEN(b.x)]) == gen, bar);
            __builtin_amdgcn_fence(__ATOMIC_ACQUIRE, "agent");
            asm volatile("s_waitcnt vmcnt(0)" ::: "memory");
        }
    }
    __syncthreads();
}
constexpr int DM = 2048, NTOK = 8192, NCTX = 4096, PROJW = 4864, FFNH = 5632, MODW = 12288;
constexpr int C_SQ = 0, C_SK = 512, C_SV = 640, C_NQ = 768, C_NK = 1280, C_NV = 1792, C_DQ = 2304, C_DK = 2816, C_DV = 3328, C_LX = 3840, C_LG = 4352;
constexpr size_t O_Y = 0, O_SWAK = 16777216, O_SWAV = 17825792, O_NAK = 18874368, O_NAV = 23068672, O_DFK = 27262976, O_DFV = 31457280, O_LRU = 35651584;
constexpr size_t MiB = 1u << 20;
constexpr size_t WS_CTL = 0, CTL_ZERO_BYTES = 65536;
constexpr int KSPLIT = 16;
constexpr size_t WS_MODP = 2 * MiB;
constexpr size_t WS_MODV = 10 * MiB;
constexpr size_t WS_ROPE = 11 * MiB;
constexpr size_t WS_WIN = 12 * MiB;
constexpr size_t WS_WOUT = 52 * MiB;
constexpr size_t WS_WGU = 68 * MiB;
constexpr size_t WS_WDN = 156 * MiB;
constexpr size_t WS_H = 200 * MiB;
constexpr size_t WS_MIX = 232 * MiB;
constexpr size_t WS_HM = 264 * MiB;
constexpr size_t WS_QKF = 352 * MiB;
constexpr size_t WS_U = 504 * MiB;
constexpr size_t WS_AB = 420 * MiB;
constexpr size_t WS_LW = 520 * MiB;
constexpr size_t WS_HS = 584 * MiB;
constexpr size_t WS_PB = 616 * MiB;
constexpr size_t WS_VT = 692 * MiB;
constexpr size_t WS_CKB = 712 * MiB;
constexpr size_t WS_CVT = 717 * MiB;
constexpr size_t WS_END = 722 * MiB;
constexpr int CW_BAR = 4096;

constexpr int NWAVES = 8;
constexpr int RING_BYTES = 131072, LDSCTL_OFF = RING_BYTES, MISC_OFF = LDSCTL_OFF + 320, LDS_BYTES = 147456;

__device__ __forceinline__ float bf2f(unsigned short b) { return __builtin_bit_cast(float, (unsigned)b << 16); }

struct EpiF32P {
    static constexpr bool PERM = false, AFTER_DRAIN = false;
    float* C; int ldc;
    __device__ __forceinline__ void operator()(const pg8::f32x4 (&acc)[2][2][4][2], const pg8::Unit& u, int wr, int wc, int fr, int fq) const {
        const int row0 = u.pm * 256 + wr * 64 + fr, col0 = u.pn * 256 + wc * 32 + 4 * fq;
#pragma unroll
        for (int ai = 0; ai < 2; ++ai)
#pragma unroll
            for (int m = 0; m < 4; ++m) { float* rowp = C + (size_t)(row0 + ai * 128 + m * 16) * ldc + col0;
#pragma unroll
                for (int bj = 0; bj < 2; ++bj)
#pragma unroll
                    for (int n = 0; n < 2; ++n) *(pg8::f32x4*)(rowp + bj * 128 + n * 16) = acc[ai][bj][m][n]; }
    }
};
struct EpiResid {
    static constexpr bool PERM = false, AFTER_DRAIN = false;
    const float* b0; const float* b1; float* out; const float* gate;
    __device__ __forceinline__ void operator()(const pg8::f32x4 (&acc)[2][2][4][2], const pg8::Unit& u, int wr, int wc, int fr, int fq) const {
        const int v = u.pm < 16 ? 0 : 1 + ((u.pm - 16) >> 2);
        const float* bp = u.pm < 16 ? b0 + (size_t)u.pm * 256 * DM : b1 + (size_t)(u.pm - 16) * 256 * DM;
        float* op = out + (size_t)u.pm * 256 * DM;
        const int r0 = wr * 64 + fr, col0 = u.pn * 256 + wc * 32 + 4 * fq;
        pg8::f32x4 gv[2][2];
#pragma unroll
        for (int bj = 0; bj < 2; ++bj)
#pragma unroll
            for (int n = 0; n < 2; ++n) gv[bj][n] = *(const pg8::f32x4*)(gate + (size_t)v * MODW + col0 + bj * 128 + n * 16);
#pragma unroll
        for (int ai = 0; ai < 2; ++ai)
#pragma unroll
            for (int mp = 0; mp < 2; ++mp) {
                pg8::f32x4 bs[2][2][2];
#pragma unroll
                for (int mm = 0; mm < 2; ++mm) { const size_t off = (size_t)(r0 + ai * 128 + (2 * mp + mm) * 16) * DM + col0;
#pragma unroll
                    for (int bj = 0; bj < 2; ++bj)
#pragma unroll
                        for (int n = 0; n < 2; ++n) bs[mm][bj][n] = *(const pg8::f32x4*)(bp + off + bj * 128 + n * 16); }
#pragma unroll
                for (int mm = 0; mm < 2; ++mm) { const size_t off = (size_t)(r0 + ai * 128 + (2 * mp + mm) * 16) * DM + col0;
#pragma unroll
                    for (int bj = 0; bj < 2; ++bj)
#pragma unroll
                        for (int n = 0; n < 2; ++n) *(pg8::f32x4*)(op + off + bj * 128 + n * 16) = bs[mm][bj][n] + gv[bj][n] * acc[ai][bj][2 * mp + mm][n]; }
            }
    }
};
__device__ __forceinline__ float silu_f(float x) { return x * __builtin_amdgcn_rcpf(1.0f + __expf(-x)); }
struct EpiSwiGLU {
    static constexpr bool PERM = true, AFTER_DRAIN = false;
    pg8::bf16_t* O;
    __device__ __forceinline__ void operator()(const pg8::f32x4 (&acc)[2][2][4][2], const pg8::Unit& u, int wr, int wc, int fr, int fq) const {
        const int row0 = u.pm * 256 + wr * 64 + fr, col0 = u.pn * 128 + wc * 32 + 8 * fq;
#pragma unroll
        for (int ai = 0; ai < 2; ++ai)
#pragma unroll
            for (int m = 0; m < 4; ++m) { pg8::bf16_t* rowp = O + (size_t)(row0 + ai * 128 + m * 16) * FFNH + col0;
                const pg8::f32x4 g0 = acc[ai][0][m][0], g1 = acc[ai][0][m][1], u0 = acc[ai][1][m][0], u1 = acc[ai][1][m][1];
                pg8::u32x4 w;
                w.x = pk2(silu_f(g0[0]) * u0[0], silu_f(g0[1]) * u0[1]); w.y = pk2(silu_f(g0[2]) * u0[2], silu_f(g0[3]) * u0[3]);
                w.z = pk2(silu_f(g1[0]) * u1[0], silu_f(g1[1]) * u1[1]); w.w = pk2(silu_f(g1[2]) * u1[2], silu_f(g1[3]) * u1[3]);
                *(pg8::u32x4*)rowp = w; }
    }
};
struct Args {
    const float* in[32]; float* out; unsigned char* ws; int ph_lo, ph_hi; unsigned probe; unsigned pad;
};
typedef const __attribute__((address_space(4))) Args* KArgs;
struct Frame {
    LAS unsigned char* lds; int tid, lane, wave, G, bid;
    int gtid, gthreads, gwave, gwaves;
};
__device__ __forceinline__ float wave_sum(float v) {
#pragma unroll
    for (int o = 1; o < 64; o <<= 1) v += __shfl_xor(v, o);
    return v;
}
__host__ __device__ __forceinline__ int proj_slot(int a) { const int wc = a >> 6, d = a & 63; return 128 * ((d >> 4) & 1) + 32 * wc + 16 * ((d >> 2) & 1) + 4 * (2 * (d >> 5) + ((d >> 3) & 1)) + (d & 3); }
__device__ __forceinline__ int vt_pos(int t) { const int x = t & 15; return (t & ~15) + 8 * ((x >> 2) & 1) + 4 * ((x >> 3) & 1) + (x & 3); }
__device__ __forceinline__ int vec_of_row(int row) { return row < NCTX ? 0 : 1 + ((row - NCTX) >> 10); }
__device__ __forceinline__ float sigmoid_f(float x) { return 1.0f / (1.0f + __expf(-x)); }

__device__ __forceinline__ void transpose_item(const float* W, int K, int N, bf16* WT, int k0, int n0, int drow0, LAS float* scr, int lane, bool perm = false) {
#pragma unroll 8
    for (int i = 0; i < 32; ++i) { const int kk = 2 * i + (lane >> 5); scr[kk * 33 + (lane & 31)] = W[(size_t)(k0 + kk) * N + n0 + (lane & 31)]; }
    LDS_WAIT(); asm volatile("" ::: "memory");
    const int c = lane & 7;
#pragma unroll
    for (int j = 0; j < 4; ++j) { const int n = (lane >> 3) + 8 * j; const LAS float* s = scr + (8 * c) * 33 + n;
        v4u o; o.x = pk2(s[0 * 33], s[1 * 33]); o.y = pk2(s[2 * 33], s[3 * 33]); o.z = pk2(s[4 * 33], s[5 * 33]); o.w = pk2(s[6 * 33], s[7 * 33]);
        const int dr = perm ? ((n0 + n) & ~255) + proj_slot((n0 + n) & 255) : drow0 + n;
        *(GAS v4u*)(WT + (size_t)dr * K + k0 + 8 * c) = o; }
    LDS_WAIT(); asm volatile("" ::: "memory");
}

__device__ __forceinline__ void phase_prologue(const Frame& F, KArgs A) {
    LAS float* cs = (LAS float*)F.lds;
    for (int i = F.tid; i < 5 * DM; i += 512) { const int v = i / DM, k = i % DM; const float x = v == 0 ? A->in[10][k] : A->in[9][(v - 1) * DM + k]; cs[i] = x * sigmoid_f(x); }
    __syncthreads();
    float* modp = (float*)(A->ws + WS_MODP);
    for (int it = F.bid; it < 2 * KSPLIT * 24; it += F.G) {
        const int l = it / (KSPLIT * 24), r = it % (KSPLIT * 24), ks = r / 24, nc = r % 24;
        const int n = nc * 512 + F.tid, kb = ks * (DM / KSPLIT);
        const float* w = A->in[13] + (size_t)l * DM * MODW + (size_t)kb * MODW + n;
        float a0 = 0.f, a1 = 0.f, a2 = 0.f, a3 = 0.f, a4 = 0.f;
#pragma unroll 8
        for (int k = 0; k < DM / KSPLIT; ++k) { const float wv = w[(size_t)k * MODW];
            a0 += cs[0 * DM + kb + k] * wv; a1 += cs[1 * DM + kb + k] * wv; a2 += cs[2 * DM + kb + k] * wv; a3 += cs[3 * DM + kb + k] * wv; a4 += cs[4 * DM + kb + k] * wv; }
        float* o = modp + ((size_t)(l * KSPLIT + ks) * 5) * MODW + n;
        o[0 * MODW] = a0; o[1 * MODW] = a1; o[2 * MODW] = a2; o[3 * MODW] = a3; o[4 * MODW] = a4;
    }
    __syncthreads();
    {
        constexpr int S_IN = (DM / 256) * (PROJW / 128), S_OUT = (DM / 256) * (DM / 128), S_G = (DM / 256) * (FFNH / 128), S_D = (FFNH / 256) * (DM / 128);
        constexpr int S_L = S_IN + S_OUT + 2 * S_G + S_D;
        const int hr = F.lane >> 5, p = F.lane & 31, w = F.wave;
        for (int it = F.bid; it < 2 * S_L; it += F.G) {
            const int l = it / S_L; int r = it % S_L;
            const float* W; bf16* WT; int K, N, k0, n0, drow0; bool perm = false;
            if (r < S_IN) { const int nb = PROJW / 128; W = A->in[15] + (size_t)l * DM * PROJW; WT = (bf16*)(A->ws + WS_WIN) + (size_t)l * PROJW * DM; K = DM; N = PROJW; k0 = 256 * (r / nb); n0 = 128 * (r % nb); drow0 = n0; perm = true; }
            else if ((r -= S_IN) < S_OUT) { const int nb = DM / 128; W = A->in[16] + (size_t)l * DM * DM; WT = (bf16*)(A->ws + WS_WOUT) + (size_t)l * DM * DM; K = DM; N = DM; k0 = 256 * (r / nb); n0 = 128 * (r % nb); drow0 = n0; }
            else if ((r -= S_OUT) < 2 * S_G) { const int up = r >= S_G; if (up) r -= S_G; const int nb = FFNH / 128; W = A->in[up ? 30 : 29] + (size_t)l * DM * FFNH; WT = (bf16*)(A->ws + WS_WGU) + (size_t)l * 2 * FFNH * DM;
                K = DM; N = FFNH; k0 = 256 * (r / nb); n0 = 128 * (r % nb); drow0 = 256 * (n0 / 128) + (up ? 128 : 0); }
            else { r -= 2 * S_G; const int nb = DM / 128; W = A->in[31] + (size_t)l * FFNH * DM; WT = (bf16*)(A->ws + WS_WDN) + (size_t)l * DM * FFNH; K = FFNH; N = DM; k0 = 256 * (r / nb); n0 = 128 * (r % nb); drow0 = n0; }
            const float* src = W + (size_t)(k0 + 32 * w + hr) * N + n0;
#pragma unroll
            for (int i = 0; i < 16; ++i)
                __builtin_amdgcn_global_load_lds((const unsigned*)(src + (size_t)(2 * i) * N + 4 * (p ^ (4 * w + (i >> 2)))), (LAS unsigned*)(F.lds + (32 * w + 2 * i) * 512), 16, 0, 0);
            asm volatile("s_waitcnt vmcnt(0)" ::: "memory");
            __syncthreads();
            const LAS float* Lf = (const LAS float*)F.lds;
#pragma unroll
            for (int j = 0; j < 8; ++j) { const int n = 16 * w + 2 * j + hr; const LAS float* sp = Lf + (8 * p) * 128 + ((((n >> 2) ^ p) << 2) | (n & 3));
                v4u o; o.x = pk2(sp[0 * 128], sp[1 * 128]); o.y = pk2(sp[2 * 128], sp[3 * 128]); o.z = pk2(sp[4 * 128], sp[5 * 128]); o.w = pk2(sp[6 * 128], sp[7 * 128]);
                const int dr = perm ? ((n0 + n) & ~255) + proj_slot((n0 + n) & 255) : drow0 + n;
                *(GAS v4u*)(WT + (size_t)dr * K + k0 + 8 * p) = o; }
            __syncthreads();
        }
    }
    if (F.gtid < 1024) { const int pos = F.gtid >> 4, f = F.gtid & 15; const float ang = (float)pos * powf(10000.0f, -(float)f / 16.0f);
        float* rt = (float*)(A->ws + WS_ROPE); rt[F.gtid] = cosf(ang); rt[1024 + F.gtid] = sinf(ang); }
    { bf16* LW = (bf16*)(A->ws + WS_LW); constexpr int N = 2 * 2 * 2 * 8 * 64 * 64;
      for (int i0 = F.gtid; i0 < N; i0 += 4 * F.gthreads) {
          float v[4];
#pragma unroll
          for (int u = 0; u < 4; ++u) { const int i = i0 + u * F.gthreads; v[u] = 0.f;
              if (i < N) { const int c = i & 63, d = (i >> 6) & 63, blk = (i >> 12) & 7, mat = (i >> 15) & 1, ld = i >> 16; v[u] = A->in[mat ? 26 : 24][((size_t)(ld * 8 + blk) * 64 + c) * 64 + d]; } }
#pragma unroll
          for (int u = 0; u < 4; ++u) { const int i = i0 + u * F.gthreads; if (i < N) LW[i] = (bf16)f2bf(v[u]); }
      } }
    bf16* CKB = (bf16*)(A->ws + WS_CKB); bf16* CVT = (bf16*)(A->ws + WS_CVT);
    { constexpr int N = 2 * 4 * 256 * 144;
      for (int i0 = F.gtid; i0 < N; i0 += 3 * F.gthreads) {
          f32x4 v0[3], v1[3];
#pragma unroll
          for (int u = 0; u < 3; ++u) { const int i = i0 + u * F.gthreads; v0[u] = (f32x4){0.f, 0.f, 0.f, 0.f}; v1[u] = v0[u];
              if (i < N) { const int g = i % 144, r = i / 144, sk = r & 255, b = (r >> 8) & 3, l = r >> 10; const int col = 8 * g;
                  const size_t src = (size_t)(b * 2 + l) * 256 + sk;
                  const float* p = col < 128 ? A->in[2] + src * 128 + col : (col < 640 ? A->in[4] + src * 512 + col - 128 : A->in[6] + src * 512 + col - 640);
                  v0[u] = *(const f32x4*)p; v1[u] = *(const f32x4*)(p + 4); } }
#pragma unroll
          for (int u = 0; u < 3; ++u) { const int i = i0 + u * F.gthreads;
              if (i < N) { const int g = i % 144, r = i / 144, sk = r & 255, b = (r >> 8) & 3, l = r >> 10; const int col = 8 * g, cc = col >> 6, d = col & 63;
                  v4u o; o.x = pk2(v0[u].x, v0[u].y); o.y = pk2(v0[u].z, v0[u].w); o.z = pk2(v1[u].x, v1[u].y); o.w = pk2(v1[u].z, v1[u].w);
                  *(v4u*)(CKB + ((((size_t)(l * 4 + b) * 18 + cc) * 8 + (sk >> 5)) * 2048) + (d >> 4) * 512 + ((d >> 3) & 1) * 256 + (sk & 31) * 8) = o; } }
      } }
    { constexpr int N = 2 * 4 * 32 * 1152;
      for (int i0 = F.gtid; i0 < N; i0 += 3 * F.gthreads) {
          float v[3][8];
#pragma unroll
          for (int u = 0; u < 3; ++u) { const int i = i0 + u * F.gthreads;
#pragma unroll
              for (int j = 0; j < 8; ++j) v[u][j] = 0.f;
              if (i < N) { const int col = i % 1152, r = i / 1152, grp = r & 31, b = (r >> 5) & 3, l = r >> 7; const int t = grp >> 2, sp = (grp >> 1) & 1, hh = grp & 1;
                  const float* base; int stride;
                  if (col < 128) { base = A->in[3] + col; stride = 128; } else if (col < 640) { base = A->in[5] + col - 128; stride = 512; } else { base = A->in[7] + col - 640; stride = 512; }
                  base += (size_t)(b * 2 + l) * 256 * stride;
#pragma unroll
                  for (int j = 0; j < 8; ++j) { const int key = 32 * t + 16 * sp + 8 * (j >> 2) + 4 * hh + (j & 3); v[u][j] = base[(size_t)key * stride]; } } }
#pragma unroll
          for (int u = 0; u < 3; ++u) { const int i = i0 + u * F.gthreads;
              if (i < N) { const int col = i % 1152, r = i / 1152, grp = r & 31, b = (r >> 5) & 3, l = r >> 7; const int t = grp >> 2, sp = (grp >> 1) & 1, hh = grp & 1;
                  v4u o; o.x = pk2(v[u][0], v[u][1]); o.y = pk2(v[u][2], v[u][3]); o.z = pk2(v[u][4], v[u][5]); o.w = pk2(v[u][6], v[u][7]);
                  *(v4u*)(CVT + ((((size_t)(l * 4 + b) * 36 + (col >> 5)) * 8 + t) * 1024) + sp * 512 + hh * 256 + (col & 31) * 8) = o; } }
      } }
}
__device__ __forceinline__ void phase_modfinal(const Frame& F, KArgs A) {
    const float* modp = (const float*)(A->ws + WS_MODP); float* modv = (float*)(A->ws + WS_MODV);
    for (int i = F.gtid; i < 2 * 5 * MODW; i += F.gthreads) {
        const int l = i / (5 * MODW), r = i % (5 * MODW), n = r % MODW;
        float s = A->in[14][l * MODW + n];
#pragma unroll
        for (int ks = 0; ks < KSPLIT; ++ks) s += modp[(size_t)(l * KSPLIT + ks) * 5 * MODW + r];
        modv[i] = s;
    }
}
__device__ __forceinline__ void phase_modnorm(const Frame& F, KArgs A, int l, int which) {
    const float* modv = (const float*)(A->ws + WS_MODV) + (size_t)l * 5 * MODW;
    const float* g = A->in[which ? 12 : 11] + l * DM;
    bf16* H = (bf16*)(A->ws + WS_H);
    const bool from_in = (l == 0 && which == 0);
    LAS float* GS = (LAS float*)F.lds; LAS float* SH = GS + DM;
    for (int rb = F.bid; rb < NTOK / 32; rb += F.G) {
        const int rbase = rb * 32 + 4 * F.wave;
        { const int v = vec_of_row(rb * 32), c = 4 * F.tid;
          const float* sh = modv + (size_t)v * MODW + (which ? 3 : 0) * DM; const float* sc = sh + DM;
          const f32x4 gg = *(const f32x4*)(g + c); f32x4 s1, s0;
          if (from_in) {
              const float* mp = (const float*)(A->ws + WS_MODP) + (size_t)v * MODW + c;
              s0 = *(const f32x4*)(A->in[14] + c); s1 = *(const f32x4*)(A->in[14] + DM + c);
#pragma unroll
              for (int ks = 0; ks < KSPLIT; ++ks) { s0 += *(const f32x4*)(mp + (size_t)ks * 5 * MODW); s1 += *(const f32x4*)(mp + (size_t)ks * 5 * MODW + DM); }
          } else { s1 = *(const f32x4*)(sc + c); s0 = *(const f32x4*)(sh + c); }
          *(LAS f32x4*)(GS + c) = gg * (s1 + 1.0f); *(LAS f32x4*)(SH + c) = s0; }
        {
            f32x4 x[4][8]; float ss[4];
#pragma unroll
            for (int u = 0; u < 4; ++u) { const int row = rbase + u;
                const float* xr = from_in ? (row < NCTX ? A->in[0] + (size_t)row * DM : A->in[1] + (size_t)(row - NCTX) * DM) : A->out + O_Y + (size_t)row * DM;
#pragma unroll
                for (int j = 0; j < 8; ++j) x[u][j] = *(const f32x4*)(xr + 4 * F.lane + 256 * j); }
#pragma unroll
            for (int u = 0; u < 4; ++u) { ss[u] = 0.f;
#pragma unroll
                for (int j = 0; j < 8; ++j) ss[u] += (x[u][j].x * x[u][j].x + x[u][j].y * x[u][j].y) + (x[u][j].z * x[u][j].z + x[u][j].w * x[u][j].w); }
            __syncthreads();
#pragma unroll
            for (int u = 0; u < 4; ++u) { const int row = rbase + u;
                const float rs = rsqrtf(wave_sum(ss[u]) * (1.0f / DM) + 1e-6f);
#pragma unroll
                for (int j = 0; j < 8; ++j) { const int c = 4 * F.lane + 256 * j;
                    const f32x4 y = (x[u][j] * rs) * *(const LAS f32x4*)(GS + c) + *(const LAS f32x4*)(SH + c);
                    *(unsigned long long*)(H + (size_t)row * DM + c) = (unsigned long long)pk2(y.x, y.y) | ((unsigned long long)pk2(y.z, y.w) << 32); } }
        }
        __syncthreads();
    }
}
typedef float f32x16 __attribute__((ext_vector_type(16)));
typedef float f32x2 __attribute__((ext_vector_type(2)));
__device__ __forceinline__ unsigned cvtpk(float lo, float hi) { unsigned r; asm("v_cvt_pk_bf16_f32 %0, %1, %2" : "=v"(r) : "v"(lo), "v"(hi)); return r; }
__device__ __forceinline__ int crow(int r, int h) { return (r & 3) + 8 * (r >> 2) + 4 * h; }
constexpr float SM_SCALE = 0.125f * 1.4426950408889634f, LOG2E = 1.4426950408889634f;
template <int NDB, int MODE>
__device__ __forceinline__ void attn_seg(f32x16 (&o)[NDB], float& m, float& l, const bf16x8 (&qf)[4], const bf16* kb, const bf16* vb, int vdbs, int lo, int nt,
                                         int mq, int mk0, const LAS float* rpb, int h) {
    bf16x8 kf[4], kn[4];
#pragma unroll
    for (int ks = 0; ks < 4; ++ks) kf[ks] = *(const bf16x8*)(kb + ks * 512 + lo);
    for (int t = 0; t < nt; ++t) {
        const int tn = (t + 1 < nt) ? t + 1 : t;
#pragma unroll
        for (int ks = 0; ks < 4; ++ks) kn[ks] = *(const bf16x8*)(kb + (size_t)tn * 2048 + ks * 512 + lo);
        bf16x8 vf[2][NDB];
#pragma unroll
        for (int s = 0; s < 2; ++s)
#pragma unroll
            for (int db = 0; db < NDB; ++db) vf[s][db] = *(const bf16x8*)(vb + (size_t)db * vdbs + (size_t)t * 1024 + s * 512 + lo);
        f32x16 st = {0.f, 0.f, 0.f, 0.f, 0.f, 0.f, 0.f, 0.f, 0.f, 0.f, 0.f, 0.f, 0.f, 0.f, 0.f, 0.f};
#pragma unroll
        for (int ks = 0; ks < 4; ++ks) st = __builtin_amdgcn_mfma_f32_32x32x16_bf16(kf[ks], qf[ks], st, 0, 0, 0);
        float s[16];
        int mb = 0; const LAS float* rp = rpb;
        if (MODE == 1) mb = mq - mk0 - 4 * h - 32 * t + 128;
        if (MODE == 2) { int cst = mq - 8; cst = cst < 0 ? 0 : (cst > 48 ? 48 : cst); const int kcb = 32 * (t & 1) + 4 * h; mb = kcb - cst; rp = rpb + (mk0 + (t >> 1)) * 127 + (kcb - mq + 15 + 48); }
#pragma unroll
        for (int r = 0; r < 16; ++r) {
            const int cr = (r & 3) + 8 * (r >> 2);
            float v = st[r];
            if (MODE == 1) { if ((unsigned)(mb - cr) > 256u) v = -1e30f; }
            if (MODE == 2) { const bool ok = (unsigned)(mb + cr) < 16u; const float bias = rp[cr]; v = ok ? v + bias : -1e30f; }
            s[r] = v;
        }
        float mx = s[0];
#pragma unroll
        for (int r = 1; r < 16; ++r) mx = fmaxf(mx, s[r]);
        mx = fmaxf(mx, __shfl_xor(mx, 32));
        if (__any(mx > m)) {
            const float mn = fmaxf(m, mx), alpha = __builtin_amdgcn_exp2f(m - mn); m = mn; l *= alpha;
#pragma unroll
            for (int db = 0; db < NDB; ++db) o[db] = o[db] * alpha;
        }
        { const f32x2 mm = {m, m}; f32x2 acc2 = {0.f, 0.f};
#pragma unroll
          for (int r = 0; r < 16; r += 2) { f32x2 x = {s[r], s[r + 1]}; x = x - mm; x.x = __builtin_amdgcn_exp2f(x.x); x.y = __builtin_amdgcn_exp2f(x.y); acc2 += x; s[r] = x.x; s[r + 1] = x.y; }
          l += acc2.x + acc2.y; }
        v4u p0, p1;
        p0.x = cvtpk(s[0], s[1]); p0.y = cvtpk(s[2], s[3]); p0.z = cvtpk(s[4], s[5]); p0.w = cvtpk(s[6], s[7]);
        p1.x = cvtpk(s[8], s[9]); p1.y = cvtpk(s[10], s[11]); p1.z = cvtpk(s[12], s[13]); p1.w = cvtpk(s[14], s[15]);
        const bf16x8 pa0 = __builtin_bit_cast(bf16x8, p0), pa1 = __builtin_bit_cast(bf16x8, p1);
#pragma unroll
        for (int db = 0; db < NDB; ++db) { o[db] = __builtin_amdgcn_mfma_f32_32x32x16_bf16(vf[0][db], pa0, o[db], 0, 0, 0); o[db] = __builtin_amdgcn_mfma_f32_32x32x16_bf16(vf[1][db], pa1, o[db], 0, 0, 0); }
#pragma unroll
        for (int ks = 0; ks < 4; ++ks) kf[ks] = kn[ks];
    }
}
constexpr int COOP_STAGE = 16384, COOP_PARK = 65536;
__device__ __forceinline__ void attn_coop_unit(const Frame& F, KArgs A, int l, int unit) {
    const bf16* QKF = (const bf16*)(A->ws + WS_QKF); const bf16* VF = (const bf16*)(A->ws + WS_VT);
    const int b = unit >> 5, hd = (unit >> 3) & 3, qblk = unit & 7;
    const bf16* ckf = (const bf16*)(A->ws + WS_CKB) + (size_t)(l * 4 + b) * 18 * 8 * 2048; const bf16* cvf = (const bf16*)(A->ws + WS_CVT) + (size_t)(l * 4 + b) * 36 * 8 * 1024;
    bf16* MIX = (bf16*)(A->ws + WS_MIX);
    const int lane = F.lane, j = lane & 31, h = lane >> 5, lo = lane * 8, w = F.wave, ip = w >> 2;
    const int seq0 = NCTX + b * 1024, tile0 = seq0 >> 5, qtile = tile0 + qblk * 4 + (w & 3);
    auto src_piece = [&](int p, int t) -> const bf16* {
        if (p < 8) { const int c = 44 + 2 * hd + (p >> 2), ks = p & 3;
            return (t < 32 ? QKF + ((size_t)c * 256 + tile0 + t) * 2048 : ckf + ((size_t)(10 + 2 * hd + (p >> 2)) * 8 + (t - 32)) * 2048) + ks * 512 + lo; }
        const int db = (p - 8) >> 1, sh = (p - 8) & 1, vdb = 20 + 4 * hd + db;
        return (t < 32 ? VF + ((size_t)vdb * 256 + tile0 + t) * 1024 : cvf + ((size_t)vdb * 8 + (t - 32)) * 1024) + sh * 512 + lo; };
#define COOP_DMA(t, stage) do { _Pragma("unroll") for (int pp = 0; pp < 2; ++pp) { const int p_ = 2 * w + pp; \
        __builtin_amdgcn_global_load_lds((const unsigned*)src_piece(p_, (t)), (LAS unsigned*)(F.lds + (stage) * COOP_STAGE + p_ * 1024), 16, 0, 0); } } while (0)
    bf16x8 qf[4];
#pragma unroll
    for (int ks = 0; ks < 4; ++ks) qf[ks] = *(const bf16x8*)(QKF + ((size_t)(36 + 2 * hd + ip) * 256 + qtile) * 2048 + ks * 512 + lo);
    f32x16 o[4];
#pragma unroll
    for (int db = 0; db < 4; ++db) o[db] = (f32x16){0.f, 0.f, 0.f, 0.f, 0.f, 0.f, 0.f, 0.f, 0.f, 0.f, 0.f, 0.f, 0.f, 0.f, 0.f, 0.f};
    float m = -1e30f, lsum = 0.f;
#define COOP_DMA2(tp, stage) do { _Pragma("unroll") for (int u_ = 0; u_ < 2; ++u_) _Pragma("unroll") for (int pp = 0; pp < 2; ++pp) { const int p_ = 2 * w + pp; \
        __builtin_amdgcn_global_load_lds((const unsigned*)src_piece(p_, 2 * (tp) + u_), (LAS unsigned*)(F.lds + (stage) * 32768 + u_ * 16384 + p_ * 1024), 16, 0, 0); } } while (0)
    COOP_DMA2(0, 0);
    asm volatile("s_waitcnt vmcnt(0)" ::: "memory"); __syncthreads();
#pragma unroll 1
    for (int tp = 0; tp < 20; ++tp) {
        const int st_ = tp & 1;
        if (tp + 1 < 20) COOP_DMA2(tp + 1, st_ ^ 1);
        const LAS unsigned char* sb = F.lds + st_ * 32768;
        f32x16 st0 = {0.f, 0.f, 0.f, 0.f, 0.f, 0.f, 0.f, 0.f, 0.f, 0.f, 0.f, 0.f, 0.f, 0.f, 0.f, 0.f}, st1 = st0;
#pragma unroll
        for (int ks = 0; ks < 4; ++ks) { const bf16x8 k0 = *(const LAS bf16x8*)(sb + ip * 4096 + ks * 1024 + lane * 16), k1 = *(const LAS bf16x8*)(sb + 16384 + ip * 4096 + ks * 1024 + lane * 16);
            st0 = __builtin_amdgcn_mfma_f32_32x32x16_bf16(k0, qf[ks], st0, 0, 0, 0); st1 = __builtin_amdgcn_mfma_f32_32x32x16_bf16(k1, qf[ks], st1, 0, 0, 0); }
        float sc[32];
#pragma unroll
        for (int r = 0; r < 16; ++r) { sc[r] = st0[r]; sc[16 + r] = st1[r]; }
        float mx = fmaxf(sc[0], sc[16]);
#pragma unroll
        for (int r = 1; r < 16; ++r) mx = fmaxf(mx, fmaxf(sc[r], sc[16 + r]));
        mx = fmaxf(mx, __shfl_xor(mx, 32));
        if (__any(mx > m)) { const float mn = fmaxf(m, mx), alpha = __builtin_amdgcn_exp2f(m - mn); m = mn; lsum *= alpha;
#pragma unroll
            for (int db = 0; db < 4; ++db) o[db] = o[db] * alpha; }
        float ps0 = 0.f, ps1 = 0.f;
#pragma unroll
        for (int r = 0; r < 16; ++r) { sc[r] = __builtin_amdgcn_exp2f(sc[r] - m); ps0 += sc[r]; sc[16 + r] = __builtin_amdgcn_exp2f(sc[16 + r] - m); ps1 += sc[16 + r]; }
        lsum += ps0 + ps1;
#pragma unroll
        for (int u = 0; u < 2; ++u) {
            v4u p0, p1;
            p0.x = cvtpk(sc[16 * u + 0], sc[16 * u + 1]); p0.y = cvtpk(sc[16 * u + 2], sc[16 * u + 3]); p0.z = cvtpk(sc[16 * u + 4], sc[16 * u + 5]); p0.w = cvtpk(sc[16 * u + 6], sc[16 * u + 7]);
            p1.x = cvtpk(sc[16 * u + 8], sc[16 * u + 9]); p1.y = cvtpk(sc[16 * u + 10], sc[16 * u + 11]); p1.z = cvtpk(sc[16 * u + 12], sc[16 * u + 13]); p1.w = cvtpk(sc[16 * u + 14], sc[16 * u + 15]);
            const bf16x8 pa0 = __builtin_bit_cast(bf16x8, p0), pa1 = __builtin_bit_cast(bf16x8, p1);
#pragma unroll
            for (int db = 0; db < 4; ++db) { const bf16x8 v0 = *(const LAS bf16x8*)(sb + u * 16384 + 8192 + (db * 2) * 1024 + lane * 16), v1 = *(const LAS bf16x8*)(sb + u * 16384 + 8192 + (db * 2 + 1) * 1024 + lane * 16);
                o[db] = __builtin_amdgcn_mfma_f32_32x32x16_bf16(v0, pa0, o[db], 0, 0, 0); o[db] = __builtin_amdgcn_mfma_f32_32x32x16_bf16(v1, pa1, o[db], 0, 0, 0); }
        }
        asm volatile("s_waitcnt vmcnt(0)" ::: "memory"); __syncthreads();
    }
#undef COOP_DMA2
#undef COOP_DMA
    lsum += __shfl_xor(lsum, 32);
    const float il = 1.0f / lsum;
    LAS float* parkw = (LAS float*)(F.lds + COOP_PARK + (w & 3) * 16384) + lane;
    if (ip == 0) {
#pragma unroll
        for (int db = 0; db < 4; ++db)
#pragma unroll
            for (int r = 0; r < 16; ++r) parkw[(db * 16 + r) * 64] = o[db][r] * il;
    }
    __syncthreads();
    if (ip == 1) {
        const float* lp = A->in[20] + l * 256;
        const float s1 = wave_sum(lp[lane] * lp[64 + lane]), s2 = wave_sum(lp[128 + lane] * lp[192 + lane]);
        int lq_ = l; asm volatile("" : "+s"(lq_));
        const float lam_init = lq_ == 0 ? 0.2f : 0.35550906f; const float lam = expf(s1) - expf(s2) + lam_init;
        float ss = 0.f;
#pragma unroll
        for (int db = 0; db < 4; ++db)
#pragma unroll
            for (int r = 0; r < 16; ++r) { const float x = parkw[(db * 16 + r) * 64] - lam * (o[db][r] * il); o[db][r] = x; ss += x * x; }
        ss += __shfl_xor(ss, 32);
        const float rs = rsqrtf(ss * (1.0f / 128.0f) + 1e-6f) * (1.0f - lam_init);
        const float* sub = A->in[21] + l * 128;
        bf16* orow = MIX + (size_t)(seq0 + (qblk * 4 + (w & 3)) * 32 + j) * DM + 1024 + 128 * hd;
#pragma unroll
        for (int db = 0; db < 4; ++db)
#pragma unroll
            for (int g = 0; g < 4; ++g) { const int d = 32 * db + 8 * g + 4 * h; const f32x4 sv = *(const f32x4*)(sub + d);
                *(unsigned long long*)(orow + d) = (unsigned long long)cvtpk(o[db][4 * g] * rs * sv.x, o[db][4 * g + 1] * rs * sv.y) | ((unsigned long long)cvtpk(o[db][4 * g + 2] * rs * sv.z, o[db][4 * g + 3] * rs * sv.w) << 32); }
    }
    __syncthreads();
}
constexpr int CW_Q = 8192;
constexpr int N_ITEMS = 5120;
__device__ __forceinline__ void phase_attn(const Frame& F, KArgs A, int l, int rep) {
    const bf16* QKF = (const bf16*)(A->ws + WS_QKF); const bf16* VF = (const bf16*)(A->ws + WS_VT);
    const bf16* CKF = (const bf16*)(A->ws + WS_CKB) + (size_t)l * 4 * 18 * 8 * 2048; const bf16* CVF = (const bf16*)(A->ws + WS_CVT) + (size_t)l * 4 * 36 * 8 * 1024;
    bf16* MIX = (bf16*)(A->ws + WS_MIX);
    const int lane = F.lane, j = lane & 31, h = lane >> 5;
    const float* lp = A->in[20] + l * 256;
    const float s1 = wave_sum(lp[lane] * lp[64 + lane]), s2 = wave_sum(lp[128 + lane] * lp[192 + lane]);
    int ll_ = l; asm volatile("" : "+s"(ll_));
    const float lam_init = ll_ == 0 ? 0.2f : 0.35550906f;
    const float lam = expf(s1) - expf(s2) + lam_init;
    unsigned* ctr = (unsigned*)(A->ws + WS_CTL) + CW_Q + ((rep * 2 + l) * 8 + (F.bid & 7)) * 64;
    LAS float* park = (LAS float*)(F.lds + F.wave * 16384) + lane;
    if (F.bid >= 32 && F.bid < 160) { const int i_ = (F.bid - 32) >> 3, grp = (F.bid & 7) * 2 + (i_ >> 3); attn_coop_unit(F, A, l, grp * 8 + (i_ & 7)); }
    const bool paired = false; const int ip = 0; volatile LAS unsigned* flagA = nullptr; volatile LAS unsigned* flagB = nullptr; const unsigned tag = 0u;
    for (;;) {
        int idx;
        {
            unsigned nx = 0; if (lane == 0) nx = __hip_atomic_fetch_add(ctr, 1u, __ATOMIC_RELAXED, __HIP_MEMORY_SCOPE_AGENT);
            nx = __builtin_amdgcn_readfirstlane(nx);
            idx = (int)nx;
            if (idx >= 576) break;
        }
        const int x = F.bid & 7;
        int type, b, hd, qt;
        if (idx < 128) { type = 1; b = idx >> 5; hd = x; qt = idx & 31; }
        else if (idx < 256) { const int mm = idx - 128; type = 2; b = x >> 1; hd = (x & 1) * 4 + (mm >> 5); qt = mm & 31; }
        else if (idx < 320) { const int mm = idx - 256, g = x + 8 * (mm >> 3); type = 3; b = g >> 2; hd = g & 3; qt = mm & 7; }
        else if (idx < 448) { const int mm = idx - 320; type = 4; b = mm >> 3; hd = x; qt = mm & 7; }
        else { const int mm = idx - 448, g = x + 8 * (mm >> 5); type = 5; b = g >> 1; hd = (g & 1) * 4 + ((mm >> 3) & 3); qt = mm & 7; }
        const bool lat = type < 3;
        const int seq0 = lat ? NCTX + b * 1024 : b * 256, T = lat ? 1024 : 256, q0 = 32 * qt;
        const int tile0 = seq0 >> 5, qtile = tile0 + qt, lo = lane * 8;
        const bf16* ckf = CKF + (size_t)b * 18 * 8 * 2048; const bf16* cvf = CVF + (size_t)b * 36 * 8 * 1024;
#define QK_TILE(c, t) (QKF + ((size_t)(c) * 256 + (t)) * 2048)
#define V_TILE(vdb, t) (VF + ((size_t)(vdb) * 256 + (t)) * 1024)
        if (type == 0 || type == 3) {
            f32x16 o[4]; float m, lsum;
#pragma unroll 1
            for (int i = paired ? ip : 0; i < (paired ? ip + 1 : 2); ++i) {
                bf16x8 qf[4];
#pragma unroll
                for (int ks = 0; ks < 4; ++ks) qf[ks] = *(const bf16x8*)(QK_TILE(36 + 2 * hd + i, qtile) + ks * 512 + lo);
#pragma unroll
                for (int db = 0; db < 4; ++db) o[db] = (f32x16){0.f, 0.f, 0.f, 0.f, 0.f, 0.f, 0.f, 0.f, 0.f, 0.f, 0.f, 0.f, 0.f, 0.f, 0.f, 0.f};
                m = -1e30f; lsum = 0.f;
                attn_seg<4, 0>(o, m, lsum, qf, QK_TILE(44 + 2 * hd + i, tile0), V_TILE(20 + 4 * hd, tile0), 256 * 1024, lo, T / 32, 0, 0, (const LAS float*)nullptr, h);
                if (lat) attn_seg<4, 0>(o, m, lsum, qf, ckf + (size_t)(10 + 2 * hd + i) * 8 * 2048, cvf + (size_t)(20 + 4 * hd) * 8 * 1024, 8 * 1024, lo, 8, 0, 0, (const LAS float*)nullptr, h);
                lsum += __shfl_xor(lsum, 32);
                const float il = 1.0f / lsum;
                if (i == 0) {
#pragma unroll
                    for (int db = 0; db < 4; ++db)
#pragma unroll
                        for (int r = 0; r < 16; ++r) park[(db * 16 + r) * 64] = o[db][r] * il;
                    if (paired) { asm volatile("s_waitcnt lgkmcnt(0)" ::: "memory"); if (lane == 0) *flagA = tag;
                        while (*flagB != tag) __builtin_amdgcn_s_sleep(8); }
                } else {
                    const LAS float* parkr = paired ? park - 4096 : park;
                    if (paired) { while (*flagA != tag) __builtin_amdgcn_s_sleep(8); asm volatile("" ::: "memory"); }
                    float ss = 0.f;
#pragma unroll
                    for (int db = 0; db < 4; ++db)
#pragma unroll
                        for (int r = 0; r < 16; ++r) { const float x = parkr[(db * 16 + r) * 64] - lam * (o[db][r] * il); o[db][r] = x; ss += x * x; }
                    if (paired) { asm volatile("s_waitcnt lgkmcnt(0)" ::: "memory"); if (lane == 0) *flagB = tag; }
                    ss += __shfl_xor(ss, 32);
                    const float rs = rsqrtf(ss * (1.0f / 128.0f) + 1e-6f) * (1.0f - lam_init);
                    const float* sub = A->in[21] + l * 128;
                    bf16* orow = MIX + (size_t)(seq0 + q0 + j) * DM + 1024 + 128 * hd;
#pragma unroll
                    for (int db = 0; db < 4; ++db)
#pragma unroll
                        for (int g = 0; g < 4; ++g) { const int d = 32 * db + 8 * g + 4 * h; const f32x4 sv = *(const f32x4*)(sub + d);
                            *(unsigned long long*)(orow + d) = (unsigned long long)cvtpk(o[db][4 * g] * rs * sv.x, o[db][4 * g + 1] * rs * sv.y) | ((unsigned long long)cvtpk(o[db][4 * g + 2] * rs * sv.z, o[db][4 * g + 3] * rs * sv.w) << 32); }
                }
            }
        } else {
            const bool na = (type == 1 || type == 4);
            const int cq = na ? 12 + hd : hd, ck = na ? 20 + hd : 8 + (hd >> 2), vdb = na ? 4 + 2 * hd : 2 * (hd >> 2);
            const int cck = na ? 2 + hd : (hd >> 2);
            bf16x8 qf[4];
#pragma unroll
            for (int ks = 0; ks < 4; ++ks) qf[ks] = *(const bf16x8*)(QK_TILE(cq, qtile) + ks * 512 + lo);
            f32x16 o[2];
#pragma unroll
            for (int db = 0; db < 2; ++db) o[db] = (f32x16){0.f, 0.f, 0.f, 0.f, 0.f, 0.f, 0.f, 0.f, 0.f, 0.f, 0.f, 0.f, 0.f, 0.f, 0.f, 0.f};
            float m = -1e30f, lsum = 0.f;
            if (!lat) attn_seg<2, 0>(o, m, lsum, qf, QK_TILE(ck, tile0), V_TILE(vdb, tile0), 256 * 1024, lo, 8, 0, 0, (const LAS float*)nullptr, h);
            else {
                attn_seg<2, 0>(o, m, lsum, qf, ckf + (size_t)cck * 8 * 2048, cvf + (size_t)vdb * 8 * 1024, 8 * 1024, lo, 8, 0, 0, (const LAS float*)nullptr, h);
                if (!na) { const int k0 = q0 - 128 < 0 ? 0 : q0 - 128, k1 = q0 + 160 > 1024 ? 1024 : q0 + 160;
                    attn_seg<2, 1>(o, m, lsum, qf, QK_TILE(ck, tile0 + (k0 >> 5)), V_TILE(vdb, tile0 + (k0 >> 5)), 256 * 1024, lo, (k1 - k0) / 32, q0 + j, k0, (const LAS float*)nullptr, h); }
                else { const int r = qt >> 1, c0 = 32 * (qt & 1); int kr0 = r - 4; kr0 = kr0 < 0 ? 0 : (kr0 > 8 ? 8 : kr0);
                    LAS float* tbl = (LAS float*)(F.lds + F.wave * 16384);
                    const float* rg = A->in[19] + (size_t)(l * 8 + hd) * 465;
#pragma unroll
                    for (int i = 0; i < 8; ++i) { const int e = lane + 64 * i; if (e < 465) tbl[(e / 31) * 127 + 48 + (e % 31)] = rg[e] * LOG2E; }
                    asm volatile("s_waitcnt lgkmcnt(0)" ::: "memory");
                    attn_seg<2, 2>(o, m, lsum, qf, QK_TILE(ck, tile0 + 2 * kr0), V_TILE(vdb, tile0 + 2 * kr0), 256 * 1024, lo, 16, c0 + j, kr0 - r + 7, tbl, h); }
            }
            lsum += __shfl_xor(lsum, 32);
            if (!na) { const float sk = A->in[18][l * 8 + hd] * LOG2E; const float mn = fmaxf(m, sk), alpha = __builtin_amdgcn_exp2f(m - mn); lsum = lsum * alpha + __builtin_amdgcn_exp2f(sk - mn);
#pragma unroll
                for (int db = 0; db < 2; ++db) o[db] = o[db] * alpha; }
            const float il = 1.0f / lsum;
            bf16* orow = MIX + (size_t)(seq0 + q0 + j) * DM + (na ? 512 : 0) + hd * 64;
#pragma unroll
            for (int db = 0; db < 2; ++db)
#pragma unroll
                for (int g = 0; g < 4; ++g) { const int d = 32 * db + 8 * g + 4 * h;
                    *(unsigned long long*)(orow + d) = (unsigned long long)cvtpk(o[db][4 * g] * il, o[db][4 * g + 1] * il) | ((unsigned long long)cvtpk(o[db][4 * g + 2] * il, o[db][4 * g + 3] * il) << 32); }
        }
    }
}
__device__ __forceinline__ float gelu_tanh(float x) { const float u = 0.7978845608028654f * (x + 0.044715f * x * x * x); const float e = __builtin_amdgcn_exp2f(-2.0f * LOG2E * u); return x * __builtin_amdgcn_rcpf(1.0f + e); }
__device__ __forceinline__ float sigm(float x) { return __builtin_amdgcn_rcpf(1.0f + __builtin_amdgcn_exp2f(-LOG2E * x)); }
constexpr int LRU_UB_BYTES = 18432, LRU_XS_BYTES = 16768, LRU_UB = 0, LRU_XS = 2 * LRU_UB_BYTES;
__device__ __forceinline__ void phase_lru_gates(const Frame& F, KArgs A, int l) {
    const bf16* PB = (const bf16*)(A->ws + WS_PB); const bf16* LW = (const bf16*)(A->ws + WS_LW); float* AB = (float*)(A->ws + WS_AB);
    const int tid = F.tid, lane = F.lane, j = lane & 31, h = lane >> 5, mt = F.wave & 3, nt = F.wave >> 2;
    const int dcol = nt * 32 + j, sseg = tid >> 6, sch = tid & 63;
    const bool pairs = (F.G & 7) == 0;
#pragma unroll 1
    for (int u0 = F.bid; u0 < 512; u0 += pairs ? 2 * F.G : F.G) {
        const int nu = (pairs && u0 + F.G < 512) ? 2 : 1;
        const int blk = u0 & 7;
        const float* cw = A->in[22] + l * 2048 + blk * 64; const float cbv = A->in[23][l * 512 + blk * 64 + sch];
        const float w0 = cw[sch], w1 = cw[512 + sch], w2 = cw[1024 + sch], w3 = cw[1536 + sch];
        unsigned xv[2][17];
#pragma unroll
        for (int x = 0; x < 2; ++x) { const int u = x < nu ? u0 + x * F.G : u0; const int row0 = (u >> 3) * 128;
            const bool lat = row0 >= NCTX; const int T = lat ? 1024 : 256, t0 = lat ? (row0 & 1023) : (row0 & 255), r0 = row0 - t0;
            const bf16* lxb = PB + (size_t)r0 * PROJW + C_LX + blk * 64 + sch;
#pragma unroll
            for (int k = 0; k < 17; ++k) { int rr = sseg + 8 * k; rr = rr > 130 ? 130 : rr; const int t = t0 - 2 + rr; const int tc = t < 0 ? 0 : (t > T - 1 ? T - 1 : t); xv[x][k] = lxb[(size_t)tc * PROJW]; } }
#pragma unroll
        for (int x = 0; x < 2; ++x) { const int u = x < nu ? u0 + x * F.G : u0; const int row0 = (u >> 3) * 128;
            const bool lat = row0 >= NCTX; const int T = lat ? 1024 : 256, t0 = lat ? (row0 & 1023) : (row0 & 255);
            LAS unsigned short* XS = (LAS unsigned short*)(F.lds + LRU_XS + x * LRU_XS_BYTES);
#pragma unroll
            for (int k = 0; k < 17; ++k) { int rr = sseg + 8 * k; rr = rr > 130 ? 130 : rr; const int t = t0 - 2 + rr; XS[rr * 64 + sch] = (unsigned short)((t >= 0 && t < T) ? xv[x][k] : 0u); } }
        __syncthreads();
#pragma unroll
        for (int x = 0; x < 2; ++x) { const LAS unsigned short* XS = (const LAS unsigned short*)(F.lds + LRU_XS + x * LRU_XS_BYTES); LAS unsigned short* UB = (LAS unsigned short*)(F.lds + LRU_UB + x * LRU_UB_BYTES);
#pragma unroll
            for (int k = 0; k < 16; ++k) { const int tt = sseg + 8 * k;
                const float uu = cbv + w0 * bf2f(XS[tt * 64 + sch]) + w1 * bf2f(XS[(tt + 1) * 64 + sch]) + w2 * bf2f(XS[(tt + 2) * 64 + sch]) + w3 * bf2f(XS[(tt + 3) * 64 + sch]);
                UB[tt * 72 + sch] = (unsigned short)f2bf(uu); } }
        __syncthreads();
        bf16x8 au[2][4];
#pragma unroll
        for (int x = 0; x < 2; ++x)
#pragma unroll
            for (int ks = 0; ks < 4; ++ks) au[x][ks] = *(const LAS bf16x8*)((const LAS unsigned short*)(F.lds + LRU_UB + x * LRU_UB_BYTES) + (mt * 32 + j) * 72 + 16 * ks + 8 * h);
        const int chg = blk * 64 + dcol;
#pragma unroll 1
        for (int dir = 0; dir < 2; ++dir) {
            bf16x8 bw[2][4];
#pragma unroll
            for (int mat = 0; mat < 2; ++mat)
#pragma unroll
                for (int ks = 0; ks < 4; ++ks) bw[mat][ks] = *(const bf16x8*)(LW + ((size_t)((((l * 2 + dir) * 2 + mat) * 8 + blk) * 64 + dcol)) * 64 + 16 * ks + 8 * h);
            const float bav = A->in[25][(l * 2 + dir) * 512 + chg], bxv = A->in[27][(l * 2 + dir) * 512 + chg];
            const float Lv = A->in[28][(l * 2 + dir) * 512 + chg]; const float negk = -8.0f * LOG2E * log1pf(__expf(-Lv));
#pragma unroll
            for (int x = 0; x < 2; ++x) { if (x < nu) {
                const int row0 = ((u0 + x * F.G) >> 3) * 128; const LAS unsigned short* UB = (const LAS unsigned short*)(F.lds + LRU_UB + x * LRU_UB_BYTES);
                f32x16 ga = {0.f, 0.f, 0.f, 0.f, 0.f, 0.f, 0.f, 0.f, 0.f, 0.f, 0.f, 0.f, 0.f, 0.f, 0.f, 0.f}, gx = ga;
#pragma unroll
                for (int ks = 0; ks < 4; ++ks) { ga = __builtin_amdgcn_mfma_f32_32x32x16_bf16(au[x][ks], bw[0][ks], ga, 0, 0, 0); gx = __builtin_amdgcn_mfma_f32_32x32x16_bf16(au[x][ks], bw[1][ks], gx, 0, 0, 0); }
                float* ap = AB + ((size_t)dir * NTOK + row0 + mt * 32) * 512 + chg; float* bp = ap + (size_t)2 * NTOK * 512;
#pragma unroll
                for (int r = 0; r < 16; ++r) { const float rr = sigm(ga[r] + bav), ii = sigm(gx[r] + bxv); const float a = __builtin_amdgcn_exp2f(negk * rr);
                    const float bb = __builtin_amdgcn_sqrtf(fmaxf(1.0f - a * a, 0.f)) * (ii * bf2f(UB[(mt * 32 + crow(r, h)) * 72 + dcol]));
                    ap[(size_t)crow(r, h) * 512] = a; bp[(size_t)crow(r, h) * 512] = bb; }
            } }
        }
        __syncthreads();
    }
}
constexpr int SC_SEGA = 0, SC_SEGH = 2048, SC_CAR = 4096;
__device__ __forceinline__ void phase_lru_scan(const Frame& F, KArgs A, int l) {
    if (F.bid >= 160) return;
    const bool lat = F.bid < 32; const int ub = lat ? F.bid : F.bid - 32; const int b = ub >> 3, blk = ub & 7;
    const int r0 = lat ? NCTX + b * 1024 : b * 256, T = lat ? 1024 : 256, nc = T / 128;
    const bf16* PB = (const bf16*)(A->ws + WS_PB); const float* AB = (const float*)(A->ws + WS_AB); float* HS = (float*)(A->ws + WS_HS); bf16* MIX = (bf16*)(A->ws + WS_MIX);
    const int tid = F.tid, seg = tid >> 6, sch = tid & 63, chg = blk * 64 + sch;
    LAS float* SEGA = (LAS float*)(F.lds + SC_SEGA); LAS float* SEGH = (LAS float*)(F.lds + SC_SEGH); LAS float* CAR = (LAS float*)(F.lds + SC_CAR);
    float* hs = HS + (size_t)r0 * 512 + chg;
#pragma unroll 1
    for (int dir = 0; dir < 2; ++dir) {
        const float* ap = AB + ((size_t)dir * NTOK + r0) * 512 + chg; const float* bp = ap + (size_t)2 * NTOK * 512;
        float hcarry = 0.f; if (lat && tid < 64) hcarry = A->in[8][((size_t)((b * 2 + l) * 2 + dir)) * 512 + chg];
        float av[16], bv[16];
        { const int ci = dir ? nc - 1 : 0;
#pragma unroll
          for (int k = 0; k < 16; ++k) { const int so = seg * 16 + k, tt = ci * 128 + (dir ? 127 - so : so); av[k] = ap[(size_t)tt * 512]; bv[k] = bp[(size_t)tt * 512]; } }
#pragma unroll 1
        for (int cc = 0; cc < nc; ++cc) {
            const int ci = dir ? nc - 1 - cc : cc;
            float hloc[16], pk[16]; float hl = 0.f, pp = 1.f;
#pragma unroll
            for (int k = 0; k < 16; ++k) { hl = av[k] * hl + bv[k]; pp *= av[k]; hloc[k] = hl; pk[k] = pp; }
            SEGA[seg * 64 + sch] = pp; SEGH[seg * 64 + sch] = hl;
            { const int cn = cc + 1 < nc ? cc + 1 : cc, cin_ = dir ? nc - 1 - cn : cn;
#pragma unroll
              for (int k = 0; k < 16; ++k) { const int so = seg * 16 + k, tt = cin_ * 128 + (dir ? 127 - so : so); av[k] = ap[(size_t)tt * 512]; bv[k] = bp[(size_t)tt * 512]; } }
            float hf[16]; unsigned lgv[16];
            if (dir) {
#pragma unroll
                for (int k = 0; k < 16; ++k) { const int so = seg * 16 + k, tt = ci * 128 + 127 - so; hf[k] = hs[(size_t)tt * 512]; lgv[k] = PB[(size_t)(r0 + tt) * PROJW + C_LG + chg]; }
            }
            __syncthreads();
            if (tid < 64) { float c = hcarry;
#pragma unroll
                for (int s2 = 0; s2 < 8; ++s2) { CAR[s2 * 64 + sch] = c; c = SEGA[s2 * 64 + sch] * c + SEGH[s2 * 64 + sch]; }
                hcarry = c; }
            __syncthreads();
            const float cin = CAR[seg * 64 + sch];
            if (!dir) {
#pragma unroll
                for (int k = 0; k < 16; ++k) { const int so = seg * 16 + k; hs[(size_t)(ci * 128 + so) * 512] = hloc[k] + pk[k] * cin; }
            } else {
#pragma unroll
                for (int k = 0; k < 16; ++k) { const int so = seg * 16 + k, tt = ci * 128 + 127 - so;
                    MIX[(size_t)(r0 + tt) * DM + 1536 + chg] = (bf16)f2bf((hf[k] + hloc[k] + pk[k] * cin) * gelu_tanh(bf2f((unsigned short)lgv[k]))); }
            }
        }
        if (!lat && tid < 64) A->out[O_LRU + ((size_t)((b * 2 + l) * 2 + dir)) * 512 + chg] = hcarry;
        asm volatile("s_waitcnt vmcnt(0)" ::: "memory");
        __syncthreads();
    }
}
struct EpiProj {
    static constexpr bool PERM = false, AFTER_DRAIN = false;
    bf16* PBp; bf16* QKFp; bf16* VTp; float* outp; const float* gain; const float* ropeT; int l;
    __device__ __forceinline__ void operator()(const pg8::f32x4 (&acc)[2][2][4][2], const pg8::Unit& u, int wr, int wc, int fr, int fq) const {
        asm volatile("" : "+v"(fr), "+v"(fq));
        const int c = 4 * u.pn + wc;
        int gi = -1; bool rope = false; size_t oofs = 0; int ow = 0, oc = 0, vcol0 = -1; bool hasout = false;
        if (c < 8) { gi = 0; rope = true; }
        else if (c < 10) { gi = 1; rope = true; hasout = true; oofs = O_SWAK; ow = 128; oc = c - 8; }
        else if (c < 12) { hasout = true; oofs = O_SWAV; ow = 128; oc = c - 10; vcol0 = (c - 10) * 64; }
        else if (c < 20) { gi = 2; }
        else if (c < 28) { gi = 3; hasout = true; oofs = O_NAK; ow = 512; oc = c - 20; }
        else if (c < 36) { hasout = true; oofs = O_NAV; ow = 512; oc = c - 28; vcol0 = 128 + (c - 28) * 64; }
        else if (c < 44) { gi = 4; rope = true; }
        else if (c < 52) { gi = 5; rope = true; hasout = true; oofs = O_DFK; ow = 512; oc = c - 44; }
        else if (c < 60) { hasout = true; oofs = O_DFV; ow = 512; oc = c - 52; vcol0 = 640 + (c - 52) * 64; }
        const bool lat = u.pm >= 16;
        const int dbase = 32 * (fq >> 1) + 8 * (fq & 1);
        pg8::f32x4 gv[2][2];
        if (gi >= 0) {
#pragma unroll
            for (int bj = 0; bj < 2; ++bj)
#pragma unroll
                for (int n = 0; n < 2; ++n) { gv[bj][n] = *(const pg8::f32x4*)(gain + gi * 64 + dbase + 16 * bj + 4 * n);
                    if ((gi & 1) == 0) gv[bj][n] = gv[bj][n] * SM_SCALE; }
        }
#pragma unroll
        for (int ai = 0; ai < 2; ++ai)
#pragma unroll
            for (int m = 0; m < 4; ++m) {
                const int row = u.pm * 256 + ai * 128 + wr * 64 + m * 16 + fr;
                pg8::f32x4 x[2][2];
#pragma unroll
                for (int bj = 0; bj < 2; ++bj)
#pragma unroll
                    for (int n = 0; n < 2; ++n) x[bj][n] = acc[ai][bj][m][n];
                if (gi >= 0) {
                    float ss = 0.f;
#pragma unroll
                    for (int bj = 0; bj < 2; ++bj)
#pragma unroll
                        for (int n = 0; n < 2; ++n) ss += (x[bj][n][0] * x[bj][n][0] + x[bj][n][1] * x[bj][n][1]) + (x[bj][n][2] * x[bj][n][2] + x[bj][n][3] * x[bj][n][3]);
                    ss += __shfl_xor(ss, 16); ss += __shfl_xor(ss, 32);
                    const float rs = rsqrtf(ss * (1.0f / 64.0f) + 1e-6f);
#pragma unroll
                    for (int bj = 0; bj < 2; ++bj)
#pragma unroll
                        for (int n = 0; n < 2; ++n) x[bj][n] = x[bj][n] * rs * gv[bj][n];
                    if (rope && lat) {
                        const int t = row & 1023; const int pos = (fq >> 1) ? (t & 63) : (t >> 6);
#pragma unroll
                        for (int n = 0; n < 2; ++n) { const pg8::f32x4 cs = *(const pg8::f32x4*)(ropeT + pos * 16 + 8 * (fq & 1) + 4 * n), sn = *(const pg8::f32x4*)(ropeT + 1024 + pos * 16 + 8 * (fq & 1) + 4 * n);
                            const pg8::f32x4 x1 = x[0][n], x2 = x[1][n]; x[0][n] = x1 * cs - x2 * sn; x[1][n] = x2 * cs + x1 * sn; }
                    }
                }
                if (vcol0 < 0) {
                    bf16* pr = c >= 60 ? PBp + (size_t)row * PROJW + c * 64 + dbase
                                       : QKFp + ((size_t)c * 256 + (row >> 5)) * 2048 + (2 * (fq >> 1)) * 512 + (fq & 1) * 256 + (row & 31) * 8;
                    const int bjs = c >= 60 ? 16 : 512;
#pragma unroll
                    for (int bj = 0; bj < 2; ++bj) { pg8::u32x4 w; w.x = cvtpk(x[bj][0][0], x[bj][0][1]); w.y = cvtpk(x[bj][0][2], x[bj][0][3]); w.z = cvtpk(x[bj][1][0], x[bj][1][1]); w.w = cvtpk(x[bj][1][2], x[bj][1][3]);
                        *(pg8::u32x4*)(pr + bjs * bj) = w; }
                }
                if (hasout && !lat) { float* o = outp + oofs + ((size_t)((row >> 8) * 2 + l) * 256 + (row & 255)) * ow + oc * 64 + dbase;
#pragma unroll
                    for (int bj = 0; bj < 2; ++bj)
#pragma unroll
                        for (int n = 0; n < 2; ++n) *(pg8::f32x4*)(o + 16 * bj + 4 * n) = x[bj][n]; }
                if (vcol0 >= 0) {
                    const int p = vt_pos(row & 31);
                    bf16* vt = VTp + ((size_t)((vcol0 + dbase) >> 5) * 256 + (row >> 5)) * 1024 + (p >> 3) * 256 + ((dbase & 31)) * 8 + (p & 7);
#pragma unroll
                    for (int bj = 0; bj < 2; ++bj)
#pragma unroll
                        for (int n = 0; n < 2; ++n)
#pragma unroll
                            for (int i = 0; i < 4; ++i) vt[(16 * bj + 4 * n + i) * 8] = (bf16)(cvtpk(x[bj][n][i], 0.f) & 0xffffu);
                }
            }
    }
};
#ifndef PROBE_MASK
#define PROBE_MASK 0u
#endif
__device__ __forceinline__ Frame mkframe(LAS unsigned char* lds) {
    Frame F; int tid = threadIdx.x; asm volatile("" : "+v"(tid)); int bid = blockIdx.x; asm volatile("" : "+s"(bid));
    F.lds = lds; F.tid = tid; F.lane = tid & 63; F.wave = __builtin_amdgcn_readfirstlane(tid >> 6); F.G = gridDim.x; F.bid = bid;
    F.gtid = bid * 512 + tid; F.gthreads = F.G * 512; F.gwave = bid * NWAVES + F.wave; F.gwaves = F.G * NWAVES;
    return F;
}
__global__ void __launch_bounds__(NWAVES * 64, 2) fwd_kernel(Args args) {
    extern __shared__ __attribute__((aligned(16))) unsigned char lds[];
    LAS unsigned char* L = (LAS unsigned char*)lds;
    volatile LAS unsigned* MISC = (volatile LAS unsigned*)(L + MISC_OFF);
    for (int u = threadIdx.x; u < (LDS_BYTES - LDSCTL_OFF) / 4; u += NWAVES * 64) ((LAS unsigned*)(L + LDSCTL_OFF))[u] = 0u;
    __syncthreads();
    const bool multi = (args.ph_hi - args.ph_lo) > 1;
    XcdBarrier bar; bar.bar = (unsigned*)(args.ws + WS_CTL) + CW_BAR; bar.x = 0; bar.st = nullptr;
    if (multi) bar = xcd_barrier_post((unsigned*)(args.ws + WS_CTL) + CW_BAR, MISC + 8);
    PG8_LAS unsigned char* ring = (PG8_LAS unsigned char*)lds;
#pragma unroll 1
    for (int p = args.ph_lo; p < args.ph_hi; ++p) {
      if (p == 1) continue;
#pragma unroll 1
      for (int rep = 0; rep < (int)((args.probe >> (p == 0 ? 0 : (p == 1 ? 31 : 1 + (p - 2) % 8))) & 1u) + 1; ++rep) {
        if (rep) xcd_barrier(bar);
        const Frame F = mkframe(L);
        KArgs A = (KArgs)__builtin_amdgcn_kernarg_segment_ptr(); asm volatile("" : "+s"(A));
        if (p == 0) phase_prologue(F, A);
        else if (p == 1) { }
        else {
            const int l = (p - 2) / 8, q = (p - 2) % 8;
            const float* modv = (const float*)(A->ws + WS_MODV) + (size_t)l * 5 * MODW;
            if (q == 0) { if (l == 0) phase_modfinal(F, A); phase_modnorm(F, A, l, 0); }
            else if (q == 1) {
                pg8::Gemm g{(const pg8::bf16_t*)(A->ws + WS_H), (const pg8::bf16_t*)(A->ws + WS_WIN) + (size_t)l * PROJW * DM, NTOK, PROJW, DM};
                pg8::StaticOrder S; S.init(NTOK, PROJW, F.G, F.bid);
                EpiProj E{(bf16*)(A->ws + WS_PB), (bf16*)(A->ws + WS_QKF), (bf16*)(A->ws + WS_VT), A->out, A->in[17] + l * 384, (const float*)(A->ws + WS_ROPE), l};
                pg8::gemm_phase<EpiProj, pg8::StaticOrder, true, true>(ring, g, S, E);
            }
            else if (q == 2) phase_lru_gates(F, A, l);
            else if (q == 3) { phase_lru_scan(F, A, l); phase_attn(F, A, l, rep); }
            else if (q == 4 || q == 7) {
                const bool dn = q == 7; const int kk = dn ? FFNH : DM;
                pg8::Gemm g{(const pg8::bf16_t*)(A->ws + (dn ? WS_HM : WS_MIX)), (const pg8::bf16_t*)(A->ws + (dn ? WS_WDN : WS_WOUT)) + (size_t)l * DM * kk, NTOK, DM, kk};
                pg8::StaticOrder S; S.init(NTOK, DM, F.G, F.bid);
                const bool inb = !dn && l == 0;
                EpiResid E{inb ? A->in[0] : A->out + O_Y, inb ? A->in[1] : A->out + O_Y + (size_t)NCTX * DM, A->out + O_Y, modv + (dn ? 5 : 2) * DM};
                pg8::gemm_phase<EpiResid, pg8::StaticOrder, true, true>(ring, g, S, E);
            }
            else if (q == 5) phase_modnorm(F, A, l, 1);
            else if (q == 6) {
                pg8::Gemm g{(const pg8::bf16_t*)(A->ws + WS_H), (const pg8::bf16_t*)(A->ws + WS_WGU) + (size_t)l * 2 * FFNH * DM, NTOK, 2 * FFNH, DM};
                pg8::StaticOrder S; S.init(NTOK, 2 * FFNH, F.G, F.bid);
                EpiSwiGLU E{(pg8::bf16_t*)(A->ws + WS_HM)};
                pg8::gemm_phase<EpiSwiGLU, pg8::StaticOrder, true, true>(ring, g, S, E);
            }
        }
      }
        if (p + 1 < args.ph_hi) xcd_barrier(bar);
    }
}

constexpr int N_PHASES = 18;
#ifndef ONE_LAUNCH
#define ONE_LAUNCH 1
#endif
extern "C" void kernel_launch(void* const* d_in, const int* in_sizes, int n_in, void* d_out, int out_size, void* d_ws, size_t ws_size, hipStream_t stream) {
    static int grid = 0;
    if (grid == 0) {
        if (n_in != 32 || out_size != 35684352 || ws_size < WS_END) { fprintf(stderr, "kernel_launch: unexpected shapes n_in %d out %d ws %zu\n", n_in, out_size, ws_size); grid = -1; return; }
        int dev = 0, cus = 0, per_cu = 0;
        if (hipGetDevice(&dev) != hipSuccess || hipDeviceGetAttribute(&cus, hipDeviceAttributeMultiprocessorCount, dev) != hipSuccess) { grid = -1; return; }
        if (hipFuncSetAttribute((const void*)fwd_kernel, hipFuncAttributeMaxDynamicSharedMemorySize, LDS_BYTES) != hipSuccess) { fprintf(stderr, "kernel_launch: hipFuncSetAttribute failed\n"); grid = -1; return; }
        if (hipOccupancyMaxActiveBlocksPerMultiprocessor(&per_cu, (const void*)fwd_kernel, NWAVES * 64, LDS_BYTES) != hipSuccess || per_cu < 1) fprintf(stderr, "kernel_launch: occupancy query reports %d\n", per_cu);
        (void)hipGetLastError();
        grid = cus;
    }
    if (grid < 0) return;
    if (hipMemsetAsync((char*)d_ws + WS_CTL, 0, CTL_ZERO_BYTES, stream) != hipSuccess) return;
    Args a{};
    for (int i = 0; i < 32; ++i) a.in[i] = (const float*)d_in[i];
    a.out = (float*)d_out; a.ws = (unsigned char*)d_ws;
#if ONE_LAUNCH
    a.ph_lo = 0; a.ph_hi = N_PHASES; a.probe = PROBE_MASK;
    hipLaunchKernelGGL(fwd_kernel, dim3(grid), dim3(NWAVES * 64), LDS_BYTES, stream, a);
#else
    for (int p = 0; p < N_PHASES; ++p) { a.ph_lo = p; a.ph_hi = p + 1; hipLaunchKernelGGL(fwd_kernel, dim3(grid), dim3(NWAVES * 64), LDS_BYTES, stream, a); }
#endif
}
```
